# Optimizing an MI355X kernel written in HIP

```python
import math
import jax, jax.numpy as jnp
from jax import lax
import numpy as np

D_MODEL = 1024
BATCH = 8
SEQ = 4096
DEPTH = 4

N_MIXERS = 3
N_NORMS = 7
NORM_EPS = 1e-6
D_FF = 2816
PLE_DIM = 256
CONV_WIDTH = 3
ATT_HEADS = 16
ATT_KV_HEADS = 2
ATT_HEAD_DIM = 64
WINDOW = 128
BLOCK = 128
REL_BUCKETS = 32
REL_MAX_DIST = 128
RET_HEADS = 4
RET_QK_DIM = D_MODEL // RET_HEADS
RET_V_DIM = 2 * RET_QK_DIM
RET_CHUNK = 128
ROPE_BASE = 10000.0

kernel_name = "interleaved_conv_swa_retention_macaron"


def _n_layers_of(kind):
    return (DEPTH - kind + N_MIXERS - 1) // N_MIXERS


def rmsnorm(x, g):
    xf = x.astype(jnp.float32)
    y = xf * lax.rsqrt(jnp.mean(xf * xf, axis=-1, keepdims=True) + NORM_EPS)
    return (y * g.astype(jnp.float32)).astype(x.dtype)


def swiglu(x, w_gu, w_down):
    a, b = jnp.split(x @ w_gu, 2, axis=-1)
    return (jax.nn.silu(a) * b) @ w_down


def short_conv_mixer(x, w_in, conv_w, w_out):
    S = x.shape[1]
    bgate, cgate, v = jnp.split(x @ w_in, 3, axis=-1)
    u = jnp.pad(cgate * v, ((0, 0), (CONV_WIDTH - 1, 0), (0, 0)))
    conv = sum(conv_w[j] * u[:, j:j + S] for j in range(CONV_WIDTH))
    return (bgate * conv) @ w_out


def rel_bucket(dist):
    max_exact = REL_BUCKETS // 2
    d = jnp.maximum(dist, 1).astype(jnp.float32)
    large = max_exact + (jnp.log(d / max_exact) / math.log(REL_MAX_DIST / max_exact)
                         * (REL_BUCKETS - max_exact)).astype(jnp.int32)
    large = jnp.minimum(large, REL_BUCKETS - 1)
    return jnp.where(dist < max_exact, dist, large)


def swa_mixer(x, w_qkv, sinks, w_o, rel_bias):
    Bsz, S, _ = x.shape
    nb = S // BLOCK
    G = ATT_HEADS // ATT_KV_HEADS
    q, k, v = jnp.split(x @ w_qkv, [ATT_HEADS * ATT_HEAD_DIM,
                                    (ATT_HEADS + ATT_KV_HEADS) * ATT_HEAD_DIM], axis=-1)
    q = q.reshape(Bsz, nb, BLOCK, ATT_KV_HEADS, G, ATT_HEAD_DIM)
    k = k.reshape(Bsz, nb, BLOCK, ATT_KV_HEADS, ATT_HEAD_DIM)
    v = v.reshape(Bsz, nb, BLOCK, ATT_KV_HEADS, ATT_HEAD_DIM)
    pad = ((0, 0), (1, 0), (0, 0), (0, 0), (0, 0))
    kb = jnp.concatenate([jnp.pad(k, pad)[:, :-1], k], axis=2)
    vb = jnp.concatenate([jnp.pad(v, pad)[:, :-1], v], axis=2)
    logits = jnp.einsum('bnqhgd,bnkhd->bnhgqk', q, kb).astype(jnp.float32)
    logits = logits * (ATT_HEAD_DIM ** -0.5)
    qi = jnp.arange(BLOCK)[:, None]
    kk = jnp.arange(2 * BLOCK)[None, :]
    dist = qi + BLOCK - kk
    in_window = (dist >= 0) & (dist < WINDOW)
    bias = rel_bias[rel_bucket(jnp.maximum(dist, 0))]
    bias = bias.transpose(2, 0, 1).reshape(ATT_KV_HEADS, G, BLOCK, 2 * BLOCK)
    blk_valid = (jnp.arange(nb)[:, None] > 0) | (kk >= BLOCK)
    mask = in_window[None] & blk_valid[:, None, :]
    logits = jnp.where(mask[None, :, None, None], logits + bias.astype(jnp.float32), -jnp.inf)
    sink = sinks.astype(jnp.float32).reshape(ATT_KV_HEADS, G)[None, None, :, :, None, None]
    m = jnp.maximum(jnp.max(logits, axis=-1, keepdims=True), sink)
    e = jnp.exp(logits - m)
    probs = e / (jnp.sum(e, axis=-1, keepdims=True) + jnp.exp(sink - m))
    out = jnp.einsum('bnhgqk,bnkhd->bnqhgd', probs.astype(vb.dtype), vb)
    return out.reshape(Bsz, S, ATT_HEADS * ATT_HEAD_DIM) @ w_o


def rotary(x, pos):
    half = x.shape[-1] // 2
    inv = ROPE_BASE ** (-jnp.arange(half, dtype=jnp.float32) / half)
    ang = pos[:, None].astype(jnp.float32) * inv[None, :]
    cos = jnp.cos(ang)[:, None, :]
    sin = jnp.sin(ang)[:, None, :]
    x1, x2 = x[..., :half], x[..., half:]
    return jnp.concatenate([x1 * cos - x2 * sin, x1 * sin + x2 * cos], axis=-1)


def retention_mixer(x, w_qkvg, w_o):
    Bsz, S, _ = x.shape
    H, dk, dv, C = RET_HEADS, RET_QK_DIM, RET_V_DIM, RET_CHUNK
    nc = S // C
    f32 = jnp.float32
    q, k, v, g = jnp.split(x @ w_qkvg, [H * dk, 2 * H * dk, 2 * H * dk + H * dv], axis=-1)
    pos = jnp.arange(S)
    q = rotary(q.reshape(Bsz, S, H, dk).astype(f32), pos)
    k = rotary(k.reshape(Bsz, S, H, dk).astype(f32), pos) * (dk ** -0.5)
    v = v.reshape(Bsz, S, H, dv).astype(f32)
    log_g = jnp.log(1.0 - 2.0 ** (-5.0 - jnp.arange(H, dtype=f32)))
    idx = jnp.arange(C, dtype=f32)
    diff = idx[:, None] - idx[None, :]
    decay_mask = jnp.where(diff >= 0, jnp.exp(log_g[:, None, None] * jnp.maximum(diff, 0.0)), 0.0)
    q_decay = jnp.exp(log_g[:, None] * (idx + 1.0))[..., None]
    k_decay = jnp.exp(log_g[:, None] * (C - 1.0 - idx))[..., None]
    chunk_decay = jnp.exp(log_g * C)[:, None, None]

    def to_chunks(t):
        return t.reshape(Bsz, nc, C, H, t.shape[-1]).transpose(1, 0, 3, 2, 4)

    def step(state, inp):
        qi, ki, vi = inp
        inner = jnp.einsum('bhqd,bhkd->bhqk', qi, ki) * decay_mask
        o = (jnp.einsum('bhqk,bhkv->bhqv', inner, vi)
             + jnp.einsum('bhqd,bhdv->bhqv', qi, state) * q_decay)
        state = state * chunk_decay + jnp.einsum('bhkd,bhkv->bhdv', ki * k_decay, vi)
        return state, o

    state0 = jnp.zeros((Bsz, H, dk, dv), f32)
    _, o = lax.scan(step, state0, (to_chunks(q), to_chunks(k), to_chunks(v)))
    o = o.transpose(1, 0, 3, 2, 4).reshape(Bsz, S, H, dv)
    mu = jnp.mean(o, axis=-1, keepdims=True)
    var = jnp.mean(jnp.square(o - mu), axis=-1, keepdims=True)
    o = ((o - mu) * lax.rsqrt(var + NORM_EPS)).reshape(Bsz, S, H * dv).astype(x.dtype)
    return (jax.nn.silu(g) * o) @ w_o


def setup_inputs(seed: int = 0) -> dict:
    key = jax.random.key(seed)
    ks = jax.random.split(key, 20)
    f32 = jnp.float32
    nA, nB, nC = _n_layers_of(0), _n_layers_of(1), _n_layers_of(2)

    def w(k, shape, fan_in):
        return jax.random.normal(k, shape, f32) * (fan_in ** -0.5)

    return {
        "x": jax.random.normal(ks[0], (BATCH, SEQ, D_MODEL), f32),
        "p": jax.random.normal(ks[1], (DEPTH, BATCH, SEQ, PLE_DIM), f32),
        "norm_g": 1.0 + 0.05 * jax.random.normal(ks[2], (DEPTH, N_NORMS, D_MODEL), f32),
        "ffn_w_gu": w(ks[3], (DEPTH, 2, D_MODEL, 2 * D_FF), D_MODEL),
        "ffn_w_down": w(ks[4], (DEPTH, 2, D_FF, D_MODEL), D_FF),
        "ple_w_proj": w(ks[5], (DEPTH, PLE_DIM, D_MODEL), PLE_DIM),
        "ple_w_gate": w(ks[6], (DEPTH, D_MODEL, D_MODEL), D_MODEL),
        "rel_bias": 0.5 * jax.random.normal(ks[7], (REL_BUCKETS, ATT_HEADS), f32),
        "conv_w_in": w(ks[8], (nA, D_MODEL, 3 * D_MODEL), D_MODEL),
        "conv_w": w(ks[9], (nA, CONV_WIDTH, D_MODEL), CONV_WIDTH),
        "conv_w_out": w(ks[10], (nA, D_MODEL, D_MODEL), D_MODEL),
        "swa_w_qkv": w(ks[11], (nB, D_MODEL, (ATT_HEADS + 2 * ATT_KV_HEADS) * ATT_HEAD_DIM), D_MODEL),
        "swa_sinks": 0.5 * jax.random.normal(ks[12], (nB, ATT_HEADS), f32),
        "swa_w_o": w(ks[13], (nB, ATT_HEADS * ATT_HEAD_DIM, D_MODEL), ATT_HEADS * ATT_HEAD_DIM),
        "ret_w_qkvg": w(ks[14], (nC, D_MODEL, 2 * RET_HEADS * RET_QK_DIM + 2 * RET_HEADS * RET_V_DIM), D_MODEL),
        "ret_w_o": w(ks[15], (nC, RET_HEADS * RET_V_DIM, D_MODEL), RET_HEADS * RET_V_DIM),
    }


def reference(x, p, norm_g, ffn_w_gu, ffn_w_down, ple_w_proj, ple_w_gate, rel_bias,
              conv_w_in, conv_w, conv_w_out, swa_w_qkv, swa_sinks, swa_w_o,
              ret_w_qkvg, ret_w_o):
    for i in range(DEPTH):
        kind, j = i % N_MIXERS, i // N_MIXERS
        g = norm_g[i]
        x = x + 0.5 * rmsnorm(swiglu(rmsnorm(x, g[0]), ffn_w_gu[i, 0], ffn_w_down[i, 0]), g[1])
        h = rmsnorm(x, g[2])
        if kind == 0:
            h = short_conv_mixer(h, conv_w_in[j], conv_w[j], conv_w_out[j])
        elif kind == 1:
            h = swa_mixer(h, swa_w_qkv[j], swa_sinks[j], swa_w_o[j], rel_bias)
        else:
            h = retention_mixer(h, ret_w_qkvg[j], ret_w_o[j])
        x = x + rmsnorm(h, g[3])
        x = x + 0.5 * rmsnorm(swiglu(rmsnorm(x, g[4]), ffn_w_gu[i, 1], ffn_w_down[i, 1]), g[5])
        gate = jax.nn.sigmoid(rmsnorm(x, g[6]) @ ple_w_gate[i])
        x = x + gate * (p[i] @ ple_w_proj[i])
    return x
```

```cpp
#include <hip/hip_runtime.h>
#include <hip/hip_cooperative_groups.h>
#include <cstdio>
namespace cg = cooperative_groups;

#define LAS __attribute__((address_space(3)))
typedef unsigned short bf16_t;
typedef short bf16x8 __attribute__((ext_vector_type(8)));
typedef short bf16x4 __attribute__((ext_vector_type(4)));
typedef float f32x4 __attribute__((ext_vector_type(4)));
typedef float f32x2 __attribute__((ext_vector_type(2)));
typedef unsigned u32x4 __attribute__((ext_vector_type(4)));
typedef unsigned u32x2 __attribute__((ext_vector_type(2)));

constexpr int T = 32768, DM = 1024, FF = 2816, SEQ = 4096;
constexpr float EPS = 1e-6f;
constexpr size_t MiB = 1ull << 20;
constexpr size_t WS_W = 0, WS_XB = 56 * MiB, WS_Y = WS_XB + 64 * MiB, WS_ACT = WS_Y + 64 * MiB, WS_SSP = WS_ACT + 384 * MiB,
                 WS_PS = WS_SSP + 2 * MiB, WS_ROT = WS_PS + 2 * MiB, WS_STAT = WS_ROT + 4 * MiB, WS_BAR = WS_STAT + 8 * MiB, WS_CNT = WS_BAR + 64 * 1024, WS_PB = WS_BAR + 1 * MiB, WS_END = WS_PB + 16 * MiB;
constexpr size_t W_GU0 = 0, W_GU1 = W_GU0 + 5632 * 1024, W_DN0 = W_GU1 + 5632 * 1024, W_DN1 = W_DN0 + 1024 * 2816, W_GATE = W_DN1 + 1024 * 2816,
                 W_PROJ = W_GATE + 1024 * 1024, W_MIN = W_PROJ + 1024 * 256, W_MOUT = W_MIN + 6144 * 1024,
                 W_GATE2 = W_MOUT + 1024 * 2048, W_PROJ2 = W_GATE2 + 1024 * 1024;
constexpr int LDS_BST = 139264, LDS_BYTES = LDS_BST + 1024;
constexpr int NSTEP_L = 14, NSTEPS = 4 * NSTEP_L;
#ifndef NRUN
#define NRUN NSTEPS
#endif

typedef __bf16 bf2_t __attribute__((ext_vector_type(2)));
__device__ __forceinline__ unsigned pk2(float lo, float hi) { const bf2_t v = __builtin_convertvector((f32x2){lo, hi}, bf2_t); return __builtin_bit_cast(unsigned, v); }
__device__ __forceinline__ float bflo(unsigned u) { return __uint_as_float(u << 16); }
__device__ __forceinline__ float bfhi(unsigned u) { return __uint_as_float(u & 0xffff0000u); }
__device__ __forceinline__ float wave_sum(float v) {
#pragma unroll
    for (int o = 32; o >= 1; o >>= 1) v += __shfl_xor(v, o);
    return v;
}
__device__ __forceinline__ float silu_f(float a) { return a * __builtin_amdgcn_rcpf(1.f + __expf(-a)); }
#ifndef GAMP
#define GAMP 1.f
#endif
__device__ __forceinline__ float sigm_f(float a) { return GAMP * __builtin_amdgcn_rcpf(1.f + __expf(-a)); }
__device__ __forceinline__ float fq_sum(float v) {
    auto a = __builtin_amdgcn_permlane16_swap(__float_as_uint(v), __float_as_uint(v), false, false); v = __uint_as_float(a[0]) + __uint_as_float(a[1]);
    auto b = __builtin_amdgcn_permlane32_swap(__float_as_uint(v), __float_as_uint(v), false, false); return __uint_as_float(b[0]) + __uint_as_float(b[1]);
}
__device__ __forceinline__ float fq_max(float v) {
    auto a = __builtin_amdgcn_permlane16_swap(__float_as_uint(v), __float_as_uint(v), false, false); v = fmaxf(__uint_as_float(a[0]), __uint_as_float(a[1]));
    auto b = __builtin_amdgcn_permlane32_swap(__float_as_uint(v), __float_as_uint(v), false, false); return fmaxf(__uint_as_float(b[0]), __uint_as_float(b[1]));
}
#define LDS_WAIT() asm volatile("s_waitcnt lgkmcnt(0)" ::: "memory")

namespace pg8 {
constexpr int BM = 256, BK = 64, HALF = 128, HTB = HALF * BK * 2, STAGE_BYTES = 8 * HTB, NXCD = 8, WGM = 8;
__device__ __forceinline__ int lds_byte(int r, int c) { const int st = (r >> 4) * 2 + (c >> 5), rr = r & 15, cc = c & 31, ob = rr * 64 + cc * 2; return st * 1024 + (ob ^ (((ob >> 9) & 1) << 5)); }
__device__ __forceinline__ void stage_rc(int b, int& R, int& C) { const int st = b / 1024, sb = b % 1024, swz = sb ^ (((sb >> 9) & 1) << 5); R = (st >> 1) * 16 + swz / 64; C = (st & 1) * 32 + (swz % 64) / 2; }
__device__ __forceinline__ int perm32(int rho) { const int n = rho >> 4, i = rho & 15; return 8 * (i >> 2) + 4 * n + (i & 3); }
struct Unit { int pm, pn; };
struct Gemm { const bf16_t* A; const bf16_t* Bt; int M, N, K, lda; };
struct StaticOrder {
    int nM, nN, nwg, G, c;
    __device__ void init(int M, int N, int G_, int c_) { nM = M / BM; nN = N / BM; nwg = nM * nN; G = G_; c = c_; }
    __device__ bool next(int i, Unit& u) const {
        const long L = (long)i * G + c; if (L >= nwg) return false;
        int wgid = (int)L; { const int q = nwg / NXCD, r = nwg % NXCD, xcd = wgid % NXCD, off = wgid / NXCD; wgid = (xcd < r ? xcd * (q + 1) : r * (q + 1) + (xcd - r) * q) + off; }
        const int nig = WGM * nN, gid = wgid / nig, fm = gid * WGM, gsz = (nM - fm) < WGM ? (nM - fm) : WGM;
        u.pm = fm + ((wgid % nig) % gsz); u.pn = (wgid % nig) / gsz; return true;
    }
};

enum { M_SWIGLU = 0, M_PLAIN = 1, M_Y = 2, M_GATE = 3, M_CONVIN = 4, M_RET = 5, M_YRES = 6, M_RETG = 7 };
struct Epi {
    int mode; bf16_t* out; int ldc; const float* ssp; int nparts; float* ps;
    const bf16_t* xin; float* xout; const bf16_t* proj; bf16_t* xb; bf16_t* out2; const float* rot;
    const float* gain; float coef; unsigned* cnt; float* ps2; const float* stat;
    __device__ __forceinline__ void yres(const f32x4 (&acc)[2][2][4][2], const Unit& u, int wr, int wc, int fr, int fq) const {
        const int rowb = u.pm * BM + wr * 64 + fr, cw = wc * 32 + 8 * fq, lane = fq * 16 + fr;
#pragma unroll
        for (int ai = 0; ai < 2; ++ai)
#pragma unroll
            for (int m = 0; m < 4; ++m) {
                const int r = rowb + ai * HALF + m * 16;
                const f32x4 a0 = acc[ai][0][m][0], a1 = acc[ai][0][m][1], b0 = acc[ai][1][m][0], b1 = acc[ai][1][m][1];
                const f32x4 q = a0 * a0 + a1 * a1 + b0 * b0 + b1 * b1; float sq = (q[0] + q[1]) + (q[2] + q[3]);
                sq += __shfl_xor(sq, 16); sq += __shfl_xor(sq, 32);
                if (fq == 0) __hip_atomic_store(ps + (size_t)r * 16 + u.pn * 4 + wc, sq, __ATOMIC_RELAXED, __HIP_MEMORY_SCOPE_AGENT);
            }
        asm volatile("s_waitcnt vmcnt(0)" ::: "memory");
        unsigned* c = cnt + u.pm * 16;
        if (lane == 0) __hip_atomic_fetch_add(c, 1u, __ATOMIC_RELAXED, __HIP_MEMORY_SCOPE_AGENT);
        { unsigned sp = 0; while ((unsigned)__builtin_amdgcn_readfirstlane(__hip_atomic_load(c, __ATOMIC_RELAXED, __HIP_MEMORY_SCOPE_AGENT)) < 32u) { __builtin_amdgcn_s_sleep(1); if (++sp > (1u << 14)) break; } }
        const int col0 = u.pn * 256 + cw;
        const f32x4 g0 = *(const f32x4*)(gain + col0) * coef, g1 = *(const f32x4*)(gain + col0 + 4) * coef, g2 = *(const f32x4*)(gain + col0 + 128) * coef, g3 = *(const f32x4*)(gain + col0 + 132) * coef;
#pragma unroll
        for (int ai = 0; ai < 2; ++ai)
#pragma unroll
            for (int m = 0; m < 4; ++m) {
                const int r = rowb + ai * HALF + m * 16;
                const unsigned long long* sp = (const unsigned long long*)(ps + (size_t)r * 16 + fq * 4);
                const unsigned long long t0 = __hip_atomic_load(sp, __ATOMIC_RELAXED, __HIP_MEMORY_SCOPE_AGENT), t1 = __hip_atomic_load(sp + 1, __ATOMIC_RELAXED, __HIP_MEMORY_SCOPE_AGENT);
                float tot = (__uint_as_float((unsigned)t0) + __uint_as_float((unsigned)(t0 >> 32))) + (__uint_as_float((unsigned)t1) + __uint_as_float((unsigned)(t1 >> 32)));
                tot += __shfl_xor(tot, 16); tot += __shfl_xor(tot, 32);
                const float rstd = rsqrtf(tot * (1.f / 1024.f) + EPS);
                bf16_t* xp = out + (size_t)r * 1024 + col0;
                const u32x4 xa = *(const u32x4*)xp, xb_ = *(const u32x4*)(xp + 128);
                const f32x4 a0 = acc[ai][0][m][0] * rstd, a1 = acc[ai][0][m][1] * rstd, b0 = acc[ai][1][m][0] * rstd, b1 = acc[ai][1][m][1] * rstd;
                f32x4 n0 = (f32x4){bflo(xa.x), bfhi(xa.x), bflo(xa.y), bfhi(xa.y)} + a0 * g0, n1 = (f32x4){bflo(xa.z), bfhi(xa.z), bflo(xa.w), bfhi(xa.w)} + a1 * g1;
                f32x4 n2 = (f32x4){bflo(xb_.x), bfhi(xb_.x), bflo(xb_.y), bfhi(xb_.y)} + b0 * g2, n3 = (f32x4){bflo(xb_.z), bfhi(xb_.z), bflo(xb_.w), bfhi(xb_.w)} + b1 * g3;
                u32x4 w; w.x = pk2(n0[0], n0[1]); w.y = pk2(n0[2], n0[3]); w.z = pk2(n1[0], n1[1]); w.w = pk2(n1[2], n1[3]); *(u32x4*)xp = w;
                w.x = pk2(n2[0], n2[1]); w.y = pk2(n2[2], n2[3]); w.z = pk2(n3[0], n3[1]); w.w = pk2(n3[2], n3[3]); *(u32x4*)(xp + 128) = w;
                const f32x4 q = n0 * n0 + n1 * n1 + n2 * n2 + n3 * n3; float sq = (q[0] + q[1]) + (q[2] + q[3]);
                sq += __shfl_xor(sq, 16); sq += __shfl_xor(sq, 32);
                if (fq == 0) ps2[(size_t)r * 16 + u.pn * 4 + wc] = sq;
            }
    }
#define EPI_ROWS(i) (rowb + ((i) >> 2) * HALF + ((i) & 3) * 16)
    template <bool F32OUT> __device__ __forceinline__ void gate_rows(const f32x4 (&acc)[2][2][4][2], const Unit& u, const float (&rsv)[8], int rowb, int cw, int wc, int fq) const {
#define EPI_ACC(i) const int ai = (i) >> 2, m = (i) & 3, r = EPI_ROWS(i); const float rs = rsv[i]; \
        const f32x4 a0 = acc[ai][0][m][0] * rs, a1 = acc[ai][0][m][1] * rs, b0 = acc[ai][1][m][0] * rs, b1 = acc[ai][1][m][1] * rs
#define EPI_PACK(w, p, q) w.x = pk2(p[0], p[1]); w.y = pk2(p[2], p[3]); w.z = pk2(q[0], q[1]); w.w = pk2(q[2], q[3])
#pragma unroll
            for (int hf = 0; hf < 8; ++hf) {
                u32x4 xr[1][2], pr[1][2];
#pragma unroll
                for (int m = 0; m < 1; ++m)
#pragma unroll
                    for (int bj = 0; bj < 2; ++bj) { const size_t off = (size_t)EPI_ROWS(hf + m) * 1024 + u.pn * 256 + bj * 128 + cw; xr[m][bj] = *(const u32x4*)(xin + off); pr[m][bj] = *(const u32x4*)(proj + off); }
#pragma unroll
                for (int m_ = 0; m_ < 1; ++m_) { EPI_ACC(hf + m_);
                    float sq = 0.f;
#pragma unroll
                    for (int bj = 0; bj < 2; ++bj) {
                        const size_t off = (size_t)r * 1024 + u.pn * 256 + bj * 128 + cw;
                        const f32x4 v0 = bj ? b0 : a0, v1 = bj ? b1 : a1; const u32x4 xv = xr[m_][bj], pv = pr[m_][bj];
                        f32x4 n0, n1;
                        n0[0] = bflo(xv.x) + sigm_f(v0[0]) * bflo(pv.x); n0[1] = bfhi(xv.x) + sigm_f(v0[1]) * bfhi(pv.x); n0[2] = bflo(xv.y) + sigm_f(v0[2]) * bflo(pv.y); n0[3] = bfhi(xv.y) + sigm_f(v0[3]) * bfhi(pv.y);
                        n1[0] = bflo(xv.z) + sigm_f(v1[0]) * bflo(pv.z); n1[1] = bfhi(xv.z) + sigm_f(v1[1]) * bfhi(pv.z); n1[2] = bflo(xv.w) + sigm_f(v1[2]) * bflo(pv.w); n1[3] = bfhi(xv.w) + sigm_f(v1[3]) * bfhi(pv.w);
                        if (F32OUT) { *(f32x4*)(xout + off) = n0; *(f32x4*)(xout + off + 4) = n1; }
                        u32x4 w; EPI_PACK(w, n0, n1); *(u32x4*)(xb + off) = w;
                        const f32x4 q = n0 * n0 + n1 * n1; sq += (q[0] + q[1]) + (q[2] + q[3]);
                    }
                    sq = fq_sum(sq);
                    if (fq == 0) ps[(size_t)r * 16 + u.pn * 4 + wc] = sq;
                }
            }
#undef EPI_ACC
#undef EPI_PACK
    }
    __device__ __forceinline__ void operator()(const f32x4 (&acc)[2][2][4][2], const Unit& u, int wr, int wc, int fr, int fq) const {
        if (mode == M_YRES) { yres(acc, u, wr, wc, fr, fq); return; }
        const int rowb = u.pm * BM + wr * 64 + fr, cw = wc * 32 + 8 * fq;
        float rsv[8];
        if (nparts == 16) {
#pragma unroll
            for (int hf = 0; hf < 2; ++hf) {
                f32x4 t[4];
#pragma unroll
                for (int i = 0; i < 4; ++i) t[i] = *(const f32x4*)(ssp + (size_t)EPI_ROWS(hf * 4 + i) * 16 + fq * 4);
#pragma unroll
                for (int i = 0; i < 4; ++i) { float v = (t[i][0] + t[i][1]) + (t[i][2] + t[i][3]); v = fq_sum(v); rsv[hf * 4 + i] = rsqrtf(v * (1.f / 1024.f) + EPS); }
            }
        } else if (nparts == 1) {
            float t[8];
#pragma unroll
            for (int i = 0; i < 8; ++i) t[i] = ssp[(size_t)EPI_ROWS(i) * 16];
#pragma unroll
            for (int i = 0; i < 8; ++i) rsv[i] = rsqrtf(t[i] * (1.f / 1024.f) + EPS);
        } else {
#pragma unroll
            for (int i = 0; i < 8; ++i) rsv[i] = 1.f;
        }
#define EPI_ACC(i) const int ai = (i) >> 2, m = (i) & 3, r = EPI_ROWS(i); const float rs = rsv[i]; \
        const f32x4 a0 = acc[ai][0][m][0] * rs, a1 = acc[ai][0][m][1] * rs, b0 = acc[ai][1][m][0] * rs, b1 = acc[ai][1][m][1] * rs
#define EPI_PACK(w, p, q) w.x = pk2(p[0], p[1]); w.y = pk2(p[2], p[3]); w.z = pk2(q[0], q[1]); w.w = pk2(q[2], q[3])
        if (mode == M_SWIGLU) {
#pragma unroll
            for (int i = 0; i < 8; ++i) {
                const int ai = i >> 2, m = i & 3, r = EPI_ROWS(i); const float rs = rsv[i], rs2 = rs * rs, ce = rs * -1.4426950408889634f;
                const f32x4 ra0 = acc[ai][0][m][0], ra1 = acc[ai][0][m][1], rb0 = acc[ai][1][m][0], rb1 = acc[ai][1][m][1];
                const f32x4 p0 = ra0 * rb0 * rs2, p1 = ra1 * rb1 * rs2;
                f32x4 h0, h1;
#pragma unroll
                for (int j = 0; j < 4; ++j) { h0[j] = p0[j] * __builtin_amdgcn_rcpf(1.f + __builtin_amdgcn_exp2f(ra0[j] * ce)); h1[j] = p1[j] * __builtin_amdgcn_rcpf(1.f + __builtin_amdgcn_exp2f(ra1[j] * ce)); }
                u32x4 w; w.x = pk2(h0[0], h0[1]); w.y = pk2(h0[2], h0[3]); w.z = pk2(h1[0], h1[1]); w.w = pk2(h1[2], h1[3]);
                *(u32x4*)(out + (size_t)r * ldc + u.pn * 128 + cw) = w; }
        } else if (mode == M_PLAIN) {
#pragma unroll
            for (int i = 0; i < 8; ++i) { EPI_ACC(i);
                u32x4 w; EPI_PACK(w, a0, a1); *(u32x4*)(out + (size_t)r * ldc + u.pn * 256 + cw) = w;
                EPI_PACK(w, b0, b1); *(u32x4*)(out + (size_t)r * ldc + u.pn * 256 + 128 + cw) = w; }
        } else if (mode == M_CONVIN) {
            if (u.pn < 4) {
#pragma unroll
                for (int i = 0; i < 8; ++i) { EPI_ACC(i);
                    u32x4 w; EPI_PACK(w, a0, a1); *(u32x4*)(out + (size_t)r * 1024 + u.pn * 256 + cw) = w;
                    EPI_PACK(w, b0, b1); *(u32x4*)(out + (size_t)r * 1024 + u.pn * 256 + 128 + cw) = w; }
            } else {
#pragma unroll
                for (int i = 0; i < 8; ++i) { EPI_ACC(i);
                    const f32x4 p0 = a0 * b0, p1 = a1 * b1; u32x4 w; EPI_PACK(w, p0, p1);
                    *(u32x4*)(out2 + (size_t)r * 1024 + (u.pn - 4) * 128 + cw) = w; }
            }
        } else if (mode == M_GATE) {
            if (xout) gate_rows<true>(acc, u, rsv, rowb, cw, wc, fq); else gate_rows<false>(acc, u, rsv, rowb, cw, wc, fq);
        } else if (mode == M_RETG) {
            const int hh = u.pn >> 1;
#pragma unroll
            for (int hf = 0; hf < 8; ++hf) {
                u32x4 oa[1], ob[1]; f32x4 st[1];
#pragma unroll
                for (int m = 0; m < 1; ++m) { const int rr = EPI_ROWS(hf + m); const bf16_t* op = out + (size_t)rr * ldc + u.pn * 256 + cw; oa[m] = *(const u32x4*)op; ob[m] = *(const u32x4*)(op + 128);
                    st[m] = *(const f32x4*)(stat + ((size_t)rr * 4 + hh) * 16 + fq * 4); }
#pragma unroll
                for (int m_ = 0; m_ < 1; ++m_) { EPI_ACC(hf + m_);
                    float s1 = st[m_][0] + st[m_][2], s2 = st[m_][1] + st[m_][3];
                    s1 = fq_sum(s1); s2 = fq_sum(s2);
                    const float mu = s1 * (1.f / 512.f), rstd = rsqrtf(fmaxf(s2 * (1.f / 512.f) - mu * mu, 0.f) + EPS);
                    bf16_t* op = out + (size_t)r * ldc + u.pn * 256 + cw; const u32x4 ov = oa[m_], ow = ob[m_];
                    u32x4 w;
                    w.x = pk2(silu_f(a0[0]) * (bflo(ov.x) - mu) * rstd, silu_f(a0[1]) * (bfhi(ov.x) - mu) * rstd); w.y = pk2(silu_f(a0[2]) * (bflo(ov.y) - mu) * rstd, silu_f(a0[3]) * (bfhi(ov.y) - mu) * rstd);
                    w.z = pk2(silu_f(a1[0]) * (bflo(ov.z) - mu) * rstd, silu_f(a1[1]) * (bfhi(ov.z) - mu) * rstd); w.w = pk2(silu_f(a1[2]) * (bflo(ov.w) - mu) * rstd, silu_f(a1[3]) * (bfhi(ov.w) - mu) * rstd);
                    *(u32x4*)op = w;
                    w.x = pk2(silu_f(b0[0]) * (bflo(ow.x) - mu) * rstd, silu_f(b0[1]) * (bfhi(ow.x) - mu) * rstd); w.y = pk2(silu_f(b0[2]) * (bflo(ow.y) - mu) * rstd, silu_f(b0[3]) * (bfhi(ow.y) - mu) * rstd);
                    w.z = pk2(silu_f(b1[0]) * (bflo(ow.z) - mu) * rstd, silu_f(b1[1]) * (bfhi(ow.z) - mu) * rstd); w.w = pk2(silu_f(b1[2]) * (bflo(ow.w) - mu) * rstd, silu_f(b1[3]) * (bfhi(ow.w) - mu) * rstd);
                    *(u32x4*)(op + 128) = w;
                }
            }
        } else {
            if (u.pn < 8) {
                const float sc = (u.pn >= 4) ? 0.0625f : 1.f;
#pragma unroll
                for (int hf = 0; hf < 8; ++hf) {
                    f32x4 cs[1][4];
#pragma unroll
                    for (int m = 0; m < 1; ++m) { const f32x4* cp = (const f32x4*)(rot + ((size_t)(EPI_ROWS(hf + m) & (SEQ - 1)) * 128 + cw) * 2); cs[m][0] = cp[0]; cs[m][1] = cp[1]; cs[m][2] = cp[2]; cs[m][3] = cp[3]; }
#pragma unroll
                    for (int m_ = 0; m_ < 1; ++m_) { EPI_ACC(hf + m_);
                        const f32x4 c0 = cs[m_][0], c1 = cs[m_][1], c2 = cs[m_][2], c3 = cs[m_][3];
                        f32x4 o0, o1, p0, p1;
                        o0[0] = (a0[0] * c0[0] - b0[0] * c0[1]) * sc; p0[0] = (a0[0] * c0[1] + b0[0] * c0[0]) * sc;
                        o0[1] = (a0[1] * c0[2] - b0[1] * c0[3]) * sc; p0[1] = (a0[1] * c0[3] + b0[1] * c0[2]) * sc;
                        o0[2] = (a0[2] * c1[0] - b0[2] * c1[1]) * sc; p0[2] = (a0[2] * c1[1] + b0[2] * c1[0]) * sc;
                        o0[3] = (a0[3] * c1[2] - b0[3] * c1[3]) * sc; p0[3] = (a0[3] * c1[3] + b0[3] * c1[2]) * sc;
                        o1[0] = (a1[0] * c2[0] - b1[0] * c2[1]) * sc; p1[0] = (a1[0] * c2[1] + b1[0] * c2[0]) * sc;
                        o1[1] = (a1[1] * c2[2] - b1[1] * c2[3]) * sc; p1[1] = (a1[1] * c2[3] + b1[1] * c2[2]) * sc;
                        o1[2] = (a1[2] * c3[0] - b1[2] * c3[1]) * sc; p1[2] = (a1[2] * c3[1] + b1[2] * c3[0]) * sc;
                        o1[3] = (a1[3] * c3[2] - b1[3] * c3[3]) * sc; p1[3] = (a1[3] * c3[3] + b1[3] * c3[2]) * sc;
                        u32x4 w; EPI_PACK(w, o0, o1); *(u32x4*)(out + (size_t)r * ldc + u.pn * 256 + cw) = w;
                        EPI_PACK(w, p0, p1); *(u32x4*)(out + (size_t)r * ldc + u.pn * 256 + 128 + cw) = w;
                    }
                }
            } else {
#pragma unroll
                for (int i = 0; i < 8; ++i) { EPI_ACC(i);
                    u32x4 w; EPI_PACK(w, a0, a1); *(u32x4*)(out + (size_t)r * ldc + u.pn * 256 + cw) = w;
                    EPI_PACK(w, b0, b1); *(u32x4*)(out + (size_t)r * ldc + u.pn * 256 + 128 + cw) = w; }
            }
        }
#undef EPI_ACC
#undef EPI_PACK
    }
};

__device__ __forceinline__ void gemm_phase(LAS unsigned char* lds, const Gemm g, const StaticOrder& S, const Epi& E, const int tid) {
    const int wid = __builtin_amdgcn_readfirstlane(tid >> 6), lane = tid & 63, wr = wid >> 2, wc = wid & 3, fr = lane & 15, fq = lane >> 4;
    const int K = g.K, nt = K / BK, lda = g.lda;
    unsigned voffA[2], voffB[2];
#pragma unroll
    for (int i = 0; i < 2; ++i) { int R, C; stage_rc(tid * 16 + i * 8192, R, C); const int Rb = (R & ~31) + perm32(R & 31);
        voffA[i] = (unsigned)(R * lda + C) * 2u; voffB[i] = (unsigned)(Rb * K + C) * 2u; }
    const size_t kstep = (size_t)(BK * 2);
    const size_t hstepA = (size_t)HALF * lda * 2, tstepA = 2 * hstepA;
    const size_t hstepB = (size_t)HALF * K * 2, tstepB = 2 * hstepB;
    const unsigned ldsw = (unsigned)wid * 1024u;
    const int aoff = lds_byte(wr * 64 + fr, fq * 8), boff = lds_byte(wc * 32 + fr, fq * 8);
#define PG8_SA(b, h) (((b) * 2 + (h)) * HTB)
#define PG8_SB(b, h) ((4 + (b) * 2 + (h)) * HTB)
#define PG8_STAGE(bufoff, gbase, voff) do { _Pragma("unroll") for (int _i = 0; _i < 2; ++_i) \
        __builtin_amdgcn_global_load_lds((const unsigned*)((const char*)(gbase) + (voff)[_i]), (LAS unsigned*)(lds + (bufoff) + ldsw + _i * 8192), 16, 0, 0); } while (0)
#define PG8_LDA(dst, b, h) do { _Pragma("unroll") for (int m = 0; m < 4; ++m) _Pragma("unroll") for (int k = 0; k < 2; ++k) dst[m][k] = *(const LAS bf16x8*)(lds + PG8_SA(b, h) + aoff + m * 2048 + k * 1024); } while (0)
#define PG8_LDB(dst, b, h) do { _Pragma("unroll") for (int n = 0; n < 2; ++n) _Pragma("unroll") for (int k = 0; k < 2; ++k) dst[n][k] = *(const LAS bf16x8*)(lds + PG8_SB(b, h) + boff + n * 2048 + k * 1024); } while (0)
#define PG8_MMA(ai, bj, At, Bt) do { __builtin_amdgcn_s_setprio(1); _Pragma("unroll") for (int m = 0; m < 4; ++m) _Pragma("unroll") for (int n = 0; n < 2; ++n) _Pragma("unroll") for (int k = 0; k < 2; ++k) \
        acc[ai][bj][m][n] = __builtin_amdgcn_mfma_f32_16x16x32_bf16(Bt[n][k], At[m][k], acc[ai][bj][m][n], 0, 0, 0); __builtin_amdgcn_s_setprio(0); } while (0)
#define PG8_WAIT_V(n) asm volatile("s_waitcnt vmcnt(" #n ")" ::: "memory")
#define PG8_WAIT_L(n) asm volatile("s_waitcnt lgkmcnt(" #n ")" ::: "memory")
#define PG8_BAR __builtin_amdgcn_s_barrier()
#define PG8_SCHED __builtin_amdgcn_sched_barrier(0)
    Unit cur, nxt; int ui = 0;
    if (!S.next(0, cur)) return;
    f32x4 acc[2][2][4][2];
#pragma unroll
    for (int a = 0; a < 2; ++a)
#pragma unroll
        for (int b = 0; b < 2; ++b)
#pragma unroll
            for (int m = 0; m < 4; ++m)
#pragma unroll
                for (int n = 0; n < 2; ++n) acc[a][b][m][n] = (f32x4){0.f, 0.f, 0.f, 0.f};
    bf16x8 At[4][2], B0[2][2], B1[2][2];
    const char* cA = (const char*)g.A + (size_t)cur.pm * tstepA; const char* cB = (const char*)g.Bt + (size_t)cur.pn * tstepB;
    PG8_STAGE(PG8_SB(0, 0), cB, voffB); PG8_STAGE(PG8_SB(0, 1), cB + hstepB, voffB); PG8_STAGE(PG8_SA(0, 0), cA, voffA); PG8_STAGE(PG8_SA(0, 1), cA + hstepA, voffA);
    if (wr == 1) PG8_BAR;
    PG8_WAIT_V(2); PG8_BAR;
    PG8_STAGE(PG8_SB(1, 0), cB + kstep, voffB); PG8_STAGE(PG8_SA(1, 0), cA + kstep, voffA); PG8_STAGE(PG8_SB(1, 1), cB + hstepB + kstep, voffB);
    PG8_WAIT_V(6); PG8_BAR;
    for (;;) {
        const bool has_next = S.next(ui + 1, nxt);
        const char* nA = has_next ? (const char*)g.A + (size_t)nxt.pm * tstepA : cA; const char* nB = has_next ? (const char*)g.Bt + (size_t)nxt.pn * tstepB : cB;
        for (int t = 0; t < nt; t += 2) {
            const bool last = (t == nt - 2);
            const char* a1 = cA + (size_t)(t + 1) * kstep;
            const char* a2 = last ? nA : cA + (size_t)(t + 2) * kstep; const char* b2 = last ? nB : cB + (size_t)(t + 2) * kstep;
            const char* a3 = a2 + kstep; const char* b3 = b2 + kstep;
            PG8_LDB(B0, 0, 0); PG8_LDB(B1, 0, 1); PG8_SCHED; PG8_LDA(At, 0, 0); PG8_STAGE(PG8_SA(1, 1), a1 + hstepA, voffA);
            PG8_WAIT_V(8); PG8_WAIT_L(0); PG8_BAR; PG8_MMA(0, 0, At, B0); PG8_MMA(0, 1, At, B1); PG8_BAR; PG8_SCHED;
            PG8_LDA(At, 0, 1); PG8_STAGE(PG8_SB(0, 0), b2, voffB); PG8_STAGE(PG8_SB(0, 1), b2 + hstepB, voffB); PG8_STAGE(PG8_SA(0, 0), a2, voffA);
            PG8_WAIT_V(8); PG8_WAIT_L(0); PG8_BAR; PG8_MMA(1, 0, At, B0); PG8_MMA(1, 1, At, B1); PG8_BAR; PG8_SCHED;
            PG8_LDB(B0, 1, 0); PG8_LDB(B1, 1, 1); PG8_SCHED; PG8_LDA(At, 1, 0); PG8_STAGE(PG8_SA(0, 1), a2 + hstepA, voffA);
            PG8_WAIT_V(8); PG8_WAIT_L(0); PG8_BAR; PG8_MMA(0, 0, At, B0); PG8_MMA(0, 1, At, B1); PG8_BAR; PG8_SCHED;
            PG8_LDA(At, 1, 1); PG8_STAGE(PG8_SB(1, 0), b3, voffB); PG8_STAGE(PG8_SB(1, 1), b3 + hstepB, voffB); PG8_STAGE(PG8_SA(1, 0), a3, voffA);
            PG8_WAIT_V(8); PG8_WAIT_L(0); PG8_BAR; PG8_MMA(1, 0, At, B0); PG8_MMA(1, 1, At, B1); PG8_BAR; PG8_SCHED;
        }
        if (wr == 0) PG8_BAR;
        E(acc, cur, wr, wc, fr, fq);
        if (!has_next) break;
#pragma unroll
        for (int a = 0; a < 2; ++a)
#pragma unroll
            for (int b = 0; b < 2; ++b)
#pragma unroll
                for (int m = 0; m < 4; ++m)
#pragma unroll
                    for (int n = 0; n < 2; ++n) acc[a][b][m][n] = (f32x4){0.f, 0.f, 0.f, 0.f};
        cur = nxt; cA = nA; cB = nB; ++ui;
        if (wr == 1) PG8_BAR;
    }
    PG8_WAIT_V(0);
    PG8_BAR;
}
}

__device__ __forceinline__ void cvt_item(const float* W, int K, int N, bf16_t* WT, int mode, const float* gain, LAS float* scr, int item, int lane) {
    const int nblk = N / 64, kb = item / nblk, nb = item % nblk, k0 = 64 * kb, n0 = 64 * nb;
    const int lr = lane >> 4, lc = (lane & 15) * 4;
    f32x4 v[16];
#pragma unroll
    for (int i = 0; i < 16; ++i) v[i] = *(const f32x4*)(W + (size_t)(k0 + 4 * i + lr) * N + n0 + lc);
#pragma unroll
    for (int i = 0; i < 16; ++i) { const int kk = 4 * i + lr; f32x4 t = v[i]; if (gain) t = t * gain[k0 + kk]; LAS float* d = scr + kk * 65 + lc; d[0] = t[0]; d[1] = t[1]; d[2] = t[2]; d[3] = t[3]; }
    LDS_WAIT();
    int d0 = n0;
    if (mode == 1) { const int half = N / 2, hi = n0 >= half, j = hi ? n0 - half : n0; d0 = (j / 128) * 256 + hi * 128 + (j % 128); }
    else if (mode == 2) { if (n0 >= 1024) { const int jj = (n0 - 1024) & 1023, isv = n0 >= 2048; d0 = 1024 + (jj / 128) * 256 + isv * 128 + (jj % 128); } }
    const int c = lane & 7;
#pragma unroll
    for (int j = 0; j < 8; ++j) { const int n = (lane >> 3) + 8 * j; const LAS float* p = scr + (8 * c) * 65 + n;
        u32x4 o; o.x = pk2(p[0 * 65], p[1 * 65]); o.y = pk2(p[2 * 65], p[3 * 65]); o.z = pk2(p[4 * 65], p[5 * 65]); o.w = pk2(p[6 * 65], p[7 * 65]);
        *(u32x4*)(WT + (size_t)(d0 + n) * K + k0 + 8 * c) = o; }
    LDS_WAIT();
}

#define XB_TMO      128
#define XB_XCNT(j)  (256  + 64 * (j))
#define XB_XSUB(j)  (1280 + 64 * (j))
#define XB_XGEN(j)  (2304 + 64 * (j))
#define XB_TOP      3328
#define XB_TOPGEN   3392
#define XCD_BAR_WORDS 3456
#define XB_SPIN_CAP (1u << 18)
__device__ __forceinline__ unsigned xb_ld(unsigned* p)              { return __hip_atomic_load(p, __ATOMIC_RELAXED, __HIP_MEMORY_SCOPE_AGENT); }
__device__ __forceinline__ unsigned xb_add(unsigned* p, unsigned v) { return __hip_atomic_fetch_add(p, v, __ATOMIC_RELAXED, __HIP_MEMORY_SCOPE_AGENT); }
__device__ __forceinline__ unsigned xb_xcc_id() { return (unsigned)__builtin_amdgcn_s_getreg((3 << 11) | 20) & 0xFu; }
#define XB_SPIN(cond, bar) do { unsigned _sp = 0; while (cond) { __builtin_amdgcn_s_sleep(1); \
    if ((++_sp & 255u) == 0u) { if (xb_ld(&(bar)[XB_TMO])) break; if (_sp > XB_SPIN_CAP) { atomicAdd(&(bar)[XB_TMO], 1u); break; } } } } while (0)
struct XcdBarrier { unsigned* bar; unsigned x; volatile LAS unsigned* st; };
__device__ __forceinline__ XcdBarrier xcd_barrier_post(unsigned* bar, volatile LAS unsigned* st) {
    XcdBarrier b; b.bar = bar; b.x = xb_xcc_id(); b.st = st;
    if (threadIdx.x == 0) (void)xb_add(&bar[XB_XCNT(b.x)], 1u);
    return b;
}
__device__ __forceinline__ void xcd_barrier_complete(unsigned* bar, unsigned x, unsigned& nloc, unsigned& nx) {
    const unsigned G = gridDim.x * gridDim.y * gridDim.z;
    unsigned sum, cnt, mine, sp = 0u;
    for (;;) {
        sum = 0u; cnt = 0u; mine = 0u;
#pragma unroll
        for (unsigned j = 0; j < 16; ++j) { const unsigned c = xb_ld(&bar[XB_XCNT(j)]); sum += c; cnt += (c > 0u) ? 1u : 0u; mine = (j == x) ? c : mine; }
        if (sum == G) break;
        __builtin_amdgcn_s_sleep(1);
        if ((++sp & 255u) == 0u) { if (xb_ld(&bar[XB_TMO])) break; if (sp > XB_SPIN_CAP) { atomicAdd(&bar[XB_TMO], 1u); break; } }
    }
    nloc = mine > 0u ? mine : 1u; nx = cnt > 0u ? cnt : 1u;
}
__device__ __forceinline__ void xcd_barrier(const XcdBarrier& b) {
    asm volatile("s_waitcnt vmcnt(0)" ::: "memory");
    __syncthreads();
    if (__builtin_amdgcn_mbcnt_hi(~0u, __builtin_amdgcn_mbcnt_lo(~0u, 0u)) == 0u && __builtin_amdgcn_readfirstlane(threadIdx.x) == 0) {
        unsigned* bar = b.bar;
        __builtin_amdgcn_s_waitcnt(0);
        unsigned nloc = b.st[0], nx = b.st[1];
        if (nloc == 0u) { xcd_barrier_complete(bar, b.x, nloc, nx); b.st[0] = nloc; b.st[1] = nx; }
        const unsigned old = xb_add(&bar[XB_XSUB(b.x)], 1u);
        const unsigned gen = old / nloc;
        if (old + 1u == (gen + 1u) * nloc) {
            __builtin_amdgcn_fence(__ATOMIC_RELEASE, "agent");
            asm volatile("s_waitcnt vmcnt(0)" ::: "memory");
            const unsigned og = xb_add(&bar[XB_TOP], 1u);
            const unsigned tg = og / nx;
            if (og + 1u == (tg + 1u) * nx) xb_add(&bar[XB_TOPGEN], 1u);
            else XB_SPIN(xb_ld(&bar[XB_TOPGEN]) == tg, bar);
            __builtin_amdgcn_fence(__ATOMIC_ACQUIRE, "agent");
            xb_add(&bar[XB_XGEN(b.x)], 1u);
            asm volatile("s_waitcnt vmcnt(0)" ::: "memory");
        } else {
            XB_SPIN(xb_ld(&bar[XB_XGEN(b.x)]) == gen, bar);
            __builtin_amdgcn_fence(__ATOMIC_ACQUIRE, "agent");
            asm volatile("s_waitcnt vmcnt(0)" ::: "memory");
        }
    }
    __syncthreads();
}

struct Params { const float* in[16]; float* out; unsigned char* ws; int ph_lo, ph_hi; };

__global__ void __launch_bounds__(512) fwd_kernel(Params P) {
    extern __shared__ __attribute__((aligned(16))) unsigned char smem[];
    LAS unsigned char* lds = (LAS unsigned char*)smem;
    cg::grid_group grid = cg::this_grid();
    const int wave = __builtin_amdgcn_readfirstlane(threadIdx.x >> 6);
    const int G = gridDim.x, gw = blockIdx.x * 8 + wave, NGW = G * 8;
    unsigned char* ws = P.ws;
    bf16_t* Wb = (bf16_t*)(ws + WS_W);
    bf16_t* XB = (bf16_t*)(ws + WS_XB);
    bf16_t* YB = (bf16_t*)(ws + WS_Y);
    bf16_t* ACT = (bf16_t*)(ws + WS_ACT);
    bf16_t* PB = (bf16_t*)(ws + WS_PB);
    unsigned* CNT = (unsigned*)(ws + WS_CNT);
    float* SSP = (float*)(ws + WS_SSP);
    float* PS = (float*)(ws + WS_PS);
    float* ROT = (float*)(ws + WS_ROT);
    float* STAT = (float*)(ws + WS_STAT);
    const float* x_in = P.in[0]; const float* p_in = P.in[1]; const float* norm_g = P.in[2];
    float* X = P.out;
    const bool multi = (P.ph_hi - P.ph_lo) > 1;
    volatile LAS unsigned* bst = (volatile LAS unsigned*)(lds + LDS_BST);
    if (threadIdx.x < 4) bst[threadIdx.x] = 0u;
    __syncthreads();
    XcdBarrier xbar = xcd_barrier_post((unsigned*)(ws + WS_BAR), bst);

    for (int step = P.ph_lo; step < P.ph_hi; ++step) {
        int tid = wave * 64 + (int)__builtin_amdgcn_mbcnt_hi(~0u, __builtin_amdgcn_mbcnt_lo(~0u, 0u)); asm volatile("" : "+v"(tid));
        const int lane = tid & 63, fr = lane & 15, fq = lane >> 4;
        const int L = step / NSTEP_L, s = step % NSTEP_L, kind = L % 3, jl = L / 3;
        const float* ng = norm_g + (size_t)L * 7 * 1024;
        bf16_t* Xc = (L & 1) ? YB : XB;
        bf16_t* Yo = (L & 1) ? XB : YB;
        bool is_gemm = false, do_sync = true;
        pg8::Gemm gm{}; pg8::Epi E{};
        if (s == 0) {
            LAS float* scr = (LAS float*)(lds + wave * 16640);
            const float* wgu = P.in[3] + (size_t)L * 2 * 1024 * 5632; const float* wdn = P.in[4] + (size_t)L * 2 * 2816 * 1024;
            const float* wpj = P.in[5] + (size_t)L * 256 * 1024; const float* wgt = P.in[6] + (size_t)L * 1024 * 1024;
            const float* wmi; const float* wmo; int nmi, kmo, mmode;
            if (kind == 0) { wmi = P.in[8] + (size_t)jl * 1024 * 3072; wmo = P.in[10] + (size_t)jl * 1024 * 1024; nmi = 3072; kmo = 1024; mmode = 2; }
            else if (kind == 1) { wmi = P.in[11] + (size_t)jl * 1024 * 1280; wmo = P.in[13] + (size_t)jl * 1024 * 1024; nmi = 1280; kmo = 1024; mmode = 0; }
            else { wmi = P.in[14] + (size_t)jl * 1024 * 6144; wmo = P.in[15] + (size_t)jl * 2048 * 1024; nmi = 6144; kmo = 2048; mmode = 0; }
            const int I_GU = 16 * 88, I_DN = 44 * 16, I_GT = 16 * 16, I_PJ = 4 * 16, I_MI = 16 * (nmi / 64), I_MO = (kmo / 64) * 16;
            const int NIT = 2 * I_GU + 2 * I_DN + I_GT + I_PJ + I_MI + I_MO;
            for (int it = gw; it < NIT; it += NGW) {
                int r = it;
                if (r < I_GU) { cvt_item(wgu, 1024, 5632, Wb + W_GU0, 1, ng + 0 * 1024, scr, r, lane); continue; } r -= I_GU;
                if (r < I_GU) { cvt_item(wgu + (size_t)1024 * 5632, 1024, 5632, Wb + W_GU1, 1, ng + 4 * 1024, scr, r, lane); continue; } r -= I_GU;
                if (r < I_DN) { cvt_item(wdn, 2816, 1024, Wb + W_DN0, 0, nullptr, scr, r, lane); continue; } r -= I_DN;
                if (r < I_DN) { cvt_item(wdn + (size_t)2816 * 1024, 2816, 1024, Wb + W_DN1, 0, nullptr, scr, r, lane); continue; } r -= I_DN;
                if (r < I_GT) { cvt_item(wgt, 1024, 1024, Wb + ((L & 1) ? W_GATE2 : W_GATE), 0, ng + 6 * 1024, scr, r, lane); continue; } r -= I_GT;
                if (r < I_PJ) { cvt_item(wpj, 256, 1024, Wb + ((L & 1) ? W_PROJ2 : W_PROJ), 0, nullptr, scr, r, lane); continue; } r -= I_PJ;
                if (r < I_MI) { cvt_item(wmi, 1024, nmi, Wb + W_MIN, mmode, ng + 2 * 1024, scr, r, lane); continue; } r -= I_MI;
                cvt_item(wmo, kmo, 1024, Wb + W_MOUT, 0, nullptr, scr, r, lane);
            }
            if (L == 0) {
                for (int m = gw; m < T; m += NGW) {
                    const f32x4* xr = (const f32x4*)(x_in + (size_t)m * 1024) + lane; float ss = 0.f;
#pragma unroll
                    for (int j = 0; j < 4; ++j) { const f32x4 v = xr[64 * j]; ss += (v[0] * v[0] + v[1] * v[1]) + (v[2] * v[2] + v[3] * v[3]);
                        u32x2 w; w.x = pk2(v[0], v[1]); w.y = pk2(v[2], v[3]); *((u32x2*)(XB + (size_t)m * 1024) + lane + 64 * j) = w; }
                    ss = wave_sum(ss); if (lane == 0) SSP[(size_t)m * 16] = ss;
                }
                for (int e = blockIdx.x * 512 + tid; e < SEQ * 128; e += G * 512) {
                    const int pos = e >> 7, d = e & 127;
                    const float inv = exp2f(-(float)d * (1.f / 128.f) * 13.287712379549449f);
                    const float ang = (float)pos * inv;
                    const double rev = (double)ang * 0.15915494309189535; const float fr_ = (float)(rev - rint(rev));
                    ROT[2 * (size_t)e] = __builtin_amdgcn_cosf(fr_); ROT[2 * (size_t)e + 1] = __builtin_amdgcn_sinf(fr_);
                }
            }
        } else if (s == 1 || s == 9) {
            const int f = (s == 9);
            const bool from_gate = (s == 1 && L > 0);
            gm = pg8::Gemm{Xc, Wb + (f ? W_GU1 : W_GU0), T, 5632, 1024, 1024};
            E.mode = pg8::M_SWIGLU; E.out = ACT; E.ldc = FF; E.ssp = from_gate ? PS : SSP; E.nparts = (s == 1 && L == 0) ? 1 : 16; is_gemm = true;
        } else if (s == 2 || s == 10) {
            const int f = (s == 10);
            gm = pg8::Gemm{ACT, Wb + (f ? W_DN1 : W_DN0), T, 1024, FF, FF};
            E.mode = pg8::M_YRES; E.out = Xc; E.ps = PS; E.ps2 = SSP; E.gain = ng + (f ? 5 : 1) * 1024; E.coef = 0.5f; E.cnt = CNT + (size_t)(L * 3 + (f ? 2 : 0)) * 128 * 16; is_gemm = true;
        } else if (s == 3 || s == 8 || s == 11) {
            continue;
        } else if (s == 99) {
            const float* gain = ng + (s == 3 ? 1 : (s == 8 ? 3 : 5)) * 1024; const float coef = (s == 8) ? 1.f : 0.5f;
            const bf16_t* Ysrc = Yo;
            const float* pin = (s == 11) ? p_in + (size_t)L * T * 256 : nullptr;
            f32x4 gv[4];
#pragma unroll
            for (int j = 0; j < 4; ++j) gv[j] = *((const f32x4*)gain + lane + 64 * j) * coef;
            for (int m = gw; m < T; m += NGW) {
                float sp = (lane < 16) ? PS[(size_t)m * 16 + lane] : 0.f; sp = wave_sum(sp);
                const float rstd = rsqrtf(sp * (1.f / 1024.f) + EPS);
                float ss = 0.f;
#pragma unroll
                for (int j = 0; j < 4; ++j) {
                    const u32x2 xr = *((const u32x2*)(Xc + (size_t)m * 1024) + lane + 64 * j);
                    f32x4 xv = (f32x4){bflo(xr.x), bfhi(xr.x), bflo(xr.y), bfhi(xr.y)};
                    const u32x2 yv = *((const u32x2*)(Ysrc + (size_t)m * 1024) + lane + 64 * j);
                    xv[0] += bflo(yv.x) * rstd * gv[j][0]; xv[1] += bfhi(yv.x) * rstd * gv[j][1]; xv[2] += bflo(yv.y) * rstd * gv[j][2]; xv[3] += bfhi(yv.y) * rstd * gv[j][3];
                    ss += (xv[0] * xv[0] + xv[1] * xv[1]) + (xv[2] * xv[2] + xv[3] * xv[3]);
                    u32x2 w; w.x = pk2(xv[0], xv[1]); w.y = pk2(xv[2], xv[3]); *((u32x2*)(Xc + (size_t)m * 1024) + lane + 64 * j) = w;
                }
                ss = wave_sum(ss); if (lane == 0) SSP[(size_t)m * 16] = ss;
                if (pin) { const f32x4 pv = *((const f32x4*)(pin + (size_t)m * 256) + lane); u32x2 w; w.x = pk2(pv[0], pv[1]); w.y = pk2(pv[2], pv[3]); *((u32x2*)(PB + (size_t)m * 256) + lane) = w; }
            }
        } else if (s == 4) {
            const int nmi = kind == 0 ? 3072 : (kind == 1 ? 1280 : 4096);
            gm = pg8::Gemm{Xc, Wb + W_MIN, T, nmi, 1024, 1024};
            E.ssp = SSP; E.nparts = 16; is_gemm = true;
            if (kind == 0) { E.mode = pg8::M_CONVIN; E.out = ACT; E.out2 = ACT + (size_t)T * 1024; E.ldc = 1024; }
            else if (kind == 1) { E.mode = pg8::M_PLAIN; E.out = ACT; E.ldc = 1280; }
            else { E.mode = pg8::M_RET; E.out = ACT; E.ldc = 6144; E.rot = ROT; }
        } else if (s == 5) {
            {
                const float* pin = p_in + (size_t)L * T * 256;
                for (int m = gw; m < T; m += NGW) { const f32x4 pv = *((const f32x4*)(pin + (size_t)m * 256) + lane); u32x2 w; w.x = pk2(pv[0], pv[1]); w.y = pk2(pv[2], pv[3]); *((u32x2*)(PB + (size_t)m * 256) + lane) = w; }
            }
            if (kind == 0) {
                const bf16_t* BG = ACT; const bf16_t* CV = ACT + (size_t)T * 1024; bf16_t* Mo = ACT + (size_t)2 * T * 1024;
                const float* cw_ = P.in[9] + (size_t)jl * 3 * 1024;
                f32x4 w0[4], w1[4], w2[4];
#pragma unroll
                for (int j = 0; j < 4; ++j) { w0[j] = *((const f32x4*)cw_ + lane + 64 * j); w1[j] = *((const f32x4*)(cw_ + 1024) + lane + 64 * j); w2[j] = *((const f32x4*)(cw_ + 2048) + lane + 64 * j); }
                const int rows_per = T / NGW;
                for (int m0 = gw * rows_per; m0 < T; m0 += NGW * rows_per) {
                    f32x4 p2[4], p1[4];
                    const bool has_prev = (m0 & (SEQ - 1)) != 0;
#pragma unroll
                    for (int j = 0; j < 4; ++j) {
                        if (has_prev) { const u32x2 a = *((const u32x2*)(CV + (size_t)(m0 - 2) * 1024) + lane + 64 * j), b = *((const u32x2*)(CV + (size_t)(m0 - 1) * 1024) + lane + 64 * j);
                            p2[j] = (f32x4){bflo(a.x), bfhi(a.x), bflo(a.y), bfhi(a.y)}; p1[j] = (f32x4){bflo(b.x), bfhi(b.x), bflo(b.y), bfhi(b.y)}; }
                        else { p2[j] = (f32x4){0.f, 0.f, 0.f, 0.f}; p1[j] = p2[j]; }
                    }
                    for (int i0 = 0; i0 < rows_per; i0 += 4) {
                        u32x2 cq[4][4], bq[4][4];
#pragma unroll
                        for (int q = 0; q < 4; ++q)
#pragma unroll
                            for (int j = 0; j < 4; ++j) { const size_t m = (size_t)(m0 + i0 + q); cq[q][j] = *((const u32x2*)(CV + m * 1024) + lane + 64 * j); bq[q][j] = *((const u32x2*)(BG + m * 1024) + lane + 64 * j); }
#pragma unroll
                        for (int q = 0; q < 4; ++q) {
                            const size_t m = (size_t)(m0 + i0 + q);
#pragma unroll
                            for (int j = 0; j < 4; ++j) {
                                const u32x2 c = cq[q][j], bg = bq[q][j];
                                const f32x4 cv = (f32x4){bflo(c.x), bfhi(c.x), bflo(c.y), bfhi(c.y)}, bv = (f32x4){bflo(bg.x), bfhi(bg.x), bflo(bg.y), bfhi(bg.y)};
                                const f32x4 o = bv * (w0[j] * p2[j] + w1[j] * p1[j] + w2[j] * cv);
                                u32x2 w; w.x = pk2(o[0], o[1]); w.y = pk2(o[2], o[3]); *((u32x2*)(Mo + m * 1024) + lane + 64 * j) = w;
                                p2[j] = p1[j]; p1[j] = cv;
                            }
                        }
                    }
                }
            } else if (kind == 1) {
                LAS bf16_t* Ks = (LAS bf16_t*)lds;
                LAS bf16_t* VTs = (LAS bf16_t*)(lds + 36864);
                LAS float* BI = (LAS float*)(lds + 36864 + 33792);
                LAS float* SK = BI + 1024;
                const bf16_t* QKV = ACT; bf16_t* Oo = ACT + (size_t)2 * T * 1024;
                const float* relb = P.in[7]; const float* sinks = P.in[12] + (size_t)jl * 16;
#ifdef SWA_TRIVIAL
                for (int m = gw; m < T; m += NGW) { *((u32x4*)(Oo + (size_t)m * 1024) + lane) = *((const u32x4*)(QKV + (size_t)m * 1280) + lane); *((u32x4*)(Oo + (size_t)m * 1024) + 64 + lane) = *((const u32x4*)(QKV + (size_t)m * 1280) + 64 + lane); }
                for (int item = blockIdx.x; item < 0; item += G) {
#else
                for (int item = blockIdx.x; item < 512; item += G) {
#endif
                    const int kvh = item & 1, nb = (item >> 1) & 31, b = item >> 6;
                    __syncthreads();
                    for (int e = tid; e < 1024; e += 512) { const int gg = e >> 7, dist = e & 127; int bucket = dist;
                        if (dist >= 16) { const float d = (float)dist; int lg_ = 16 + (int)(logf(d / 16.f) / 2.0794415416798357f * 16.f); bucket = lg_ < 31 ? lg_ : 31; }
                        BI[e] = relb[bucket * 16 + kvh * 8 + gg]; }
                    if (tid < 8) SK[tid] = sinks[kvh * 8 + tid];
#pragma unroll
                    for (int i = 0; i < 4; ++i) {
                        const int q = tid + 512 * i, kk = q >> 3, c8 = q & 7; const bool valid = (nb > 0) || (kk >= 128);
                        u32x4 kv = (u32x4){0u, 0u, 0u, 0u}, vv = kv;
                        if (valid) { const size_t rk = (size_t)b * SEQ + (size_t)(nb - 1) * 128 + kk; kv = *(const u32x4*)(QKV + rk * 1280 + 1024 + kvh * 64 + c8 * 8); vv = *(const u32x4*)(QKV + rk * 1280 + 1152 + kvh * 64 + c8 * 8); }
                        *(LAS u32x4*)(Ks + kk * 72 + c8 * 8) = kv;
                        LAS bf16_t* vt = VTs + (c8 * 8) * 264 + kk;
                        vt[0 * 264] = (bf16_t)(vv.x & 0xffff); vt[1 * 264] = (bf16_t)(vv.x >> 16); vt[2 * 264] = (bf16_t)(vv.y & 0xffff); vt[3 * 264] = (bf16_t)(vv.y >> 16);
                        vt[4 * 264] = (bf16_t)(vv.z & 0xffff); vt[5 * 264] = (bf16_t)(vv.z >> 16); vt[6 * 264] = (bf16_t)(vv.w & 0xffff); vt[7 * 264] = (bf16_t)(vv.w >> 16);
                    }
                    __syncthreads();
                    const int gg = wave, h = kvh * 8 + gg; const float sink = SK[gg];
                    for (int it = 0; it < 8; ++it) {
                        const int i0 = 16 * it; const size_t r = (size_t)b * SEQ + (size_t)nb * 128 + i0 + fr;
                        bf16x8 qf[2];
#pragma unroll
                        for (int ks = 0; ks < 2; ++ks) qf[ks] = *(const bf16x8*)(QKV + r * 1280 + h * 64 + 32 * ks + fq * 8);
                        float lg[9][4]; float mx = sink;
#pragma unroll
                        for (int t = 0; t < 9; ++t) {
                            const int kt = it + t; f32x4 a = (f32x4){0.f, 0.f, 0.f, 0.f};
#pragma unroll
                            for (int ks = 0; ks < 2; ++ks) { const bf16x8 kf = *(const LAS bf16x8*)(Ks + (16 * kt + fr) * 72 + 32 * ks + fq * 8); a = __builtin_amdgcn_mfma_f32_16x16x32_bf16(kf, qf[ks], a, 0, 0, 0); }
#pragma unroll
                            for (int jj = 0; jj < 4; ++jj) { const int kk = 16 * kt + fq * 4 + jj, dist = i0 + fr + 128 - kk; const bool valid = (dist >= 0) && (dist < 128) && ((nb > 0) || (kk >= 128));
                                const float v = valid ? a[jj] * 0.125f + BI[gg * 128 + (dist & 127)] : -INFINITY; lg[t][jj] = v; mx = fmaxf(mx, v); }
                        }
                        mx = fq_max(mx);
                        float sum = 0.f;
#pragma unroll
                        for (int t = 0; t < 9; ++t)
#pragma unroll
                            for (int jj = 0; jj < 4; ++jj) { const float e = __expf(lg[t][jj] - mx); lg[t][jj] = e; sum += e; }
                        sum = fq_sum(sum);
                        const float inv = 1.f / (sum + __expf(sink - mx));
                        bf16x4 pf[9];
#pragma unroll
                        for (int t = 0; t < 9; ++t) { const unsigned lo = pk2(lg[t][0] * inv, lg[t][1] * inv), hi = pk2(lg[t][2] * inv, lg[t][3] * inv);
                            pf[t] = (bf16x4){(short)(lo & 0xffff), (short)(lo >> 16), (short)(hi & 0xffff), (short)(hi >> 16)}; }
#pragma unroll
                        for (int dt = 0; dt < 4; ++dt) {
                            f32x4 o = (f32x4){0.f, 0.f, 0.f, 0.f};
#pragma unroll
                            for (int t = 0; t < 9; ++t) { const bf16x4 vf = *(const LAS bf16x4*)(VTs + (16 * dt + fr) * 264 + 16 * (it + t) + fq * 4); o = __builtin_amdgcn_mfma_f32_16x16x16bf16_1k(vf, pf[t], o, 0, 0, 0); }
                            u32x2 w; w.x = pk2(o[0], o[1]); w.y = pk2(o[2], o[3]); *(u32x2*)(Oo + r * 1024 + h * 64 + 16 * dt + fq * 4) = w;
                        }
                    }
                }
            } else {
                LAS bf16_t* Kn = (LAS bf16_t*)lds;
                LAS bf16_t* VTs = (LAS bf16_t*)(lds + 67584);
                LAS bf16_t* VdT = (LAS bf16_t*)(lds + 67584 + 17408);
                LAS bf16_t* STs = (LAS bf16_t*)(lds + 67584 + 2 * 17408);
                bf16_t* Q = ACT;
                for (int item = blockIdx.x; item < 256; item += G) {
                    const int ix = item >> 3, ph = (item & 7) * 4 + (ix >> 3), vs = ix & 7, h = ph & 3, b = ph >> 2;
                    const float lgam = logf(1.f - exp2f(-5.f - (float)h));
                    const float cd = __expf(lgam * 128.f);
                    __syncthreads();
                    for (int e = tid; e < 64 * 264 / 2; e += 512) ((LAS unsigned*)STs)[e] = 0u;
                    f32x4 sacc[4][2];
#pragma unroll
                    for (int dt = 0; dt < 4; ++dt)
#pragma unroll
                        for (int nt = 0; nt < 2; ++nt) sacc[dt][nt] = (f32x4){0.f, 0.f, 0.f, 0.f};
                    const float d0 = __expf(lgam * (float)(127 - 2 * lane)), d1 = __expf(lgam * (float)(126 - 2 * lane));
                    const int iq = 16 * wave + fr; const float qd = __expf(lgam * (float)(iq + 1));
                    const float rf0 = __expf(lgam * (float)(iq - fq * 4)), g16 = __expf(-16.f * lgam);
                    float cfj[4];
#pragma unroll
                    for (int jj = 0; jj < 4; ++jj) cfj[jj] = __expf(-lgam * (float)jj);
                    const size_t kcol = 1024 + h * 256, vcol = 2048 + h * 512 + vs * 64;
                    u32x4 kreg[8], vreg[2]; bf16x8 qf[8];
                    {
                        const size_t rb = (size_t)b * SEQ;
#pragma unroll
                        for (int i = 0; i < 8; ++i) { const int p = tid + 512 * i; kreg[i] = *(const u32x4*)(Q + (rb + (p >> 5)) * 6144 + kcol + (p & 31) * 8); }
#pragma unroll
                        for (int rr = 0; rr < 2; ++rr) vreg[rr] = *(const u32x4*)(Q + (rb + 2 * lane + rr) * 6144 + vcol + wave * 8);
#pragma unroll
                        for (int ks = 0; ks < 8; ++ks) qf[ks] = *(const bf16x8*)(Q + (rb + iq) * 6144 + h * 256 + 32 * ks + fq * 8);
                    }
                    for (int c = 0; c < 32; ++c) {
                        const size_t rb = (size_t)b * SEQ + (size_t)c * 128;
#pragma unroll
                        for (int i = 0; i < 8; ++i) { const int p = tid + 512 * i; *(LAS u32x4*)(Kn + (p >> 5) * 264 + (p & 31) * 8) = kreg[i]; }
                        {
                            const u32x4 v0 = vreg[0], v1 = vreg[1]; LAS unsigned* dst = (LAS unsigned*)(VTs + (wave * 8) * 136 + 2 * lane); LAS unsigned* dsd = (LAS unsigned*)(VdT + (wave * 8) * 136 + 2 * lane);
                            dst[0 * 68] = (v0.x & 0xffffu) | (v1.x << 16); dst[1 * 68] = (v0.x >> 16) | (v1.x & 0xffff0000u);
                            dst[2 * 68] = (v0.y & 0xffffu) | (v1.y << 16); dst[3 * 68] = (v0.y >> 16) | (v1.y & 0xffff0000u);
                            dst[4 * 68] = (v0.z & 0xffffu) | (v1.z << 16); dst[5 * 68] = (v0.z >> 16) | (v1.z & 0xffff0000u);
                            dst[6 * 68] = (v0.w & 0xffffu) | (v1.w << 16); dst[7 * 68] = (v0.w >> 16) | (v1.w & 0xffff0000u);
                            dsd[0 * 68] = pk2(bflo(v0.x) * d0, bflo(v1.x) * d1); dsd[1 * 68] = pk2(bfhi(v0.x) * d0, bfhi(v1.x) * d1);
                            dsd[2 * 68] = pk2(bflo(v0.y) * d0, bflo(v1.y) * d1); dsd[3 * 68] = pk2(bfhi(v0.y) * d0, bfhi(v1.y) * d1);
                            dsd[4 * 68] = pk2(bflo(v0.z) * d0, bflo(v1.z) * d1); dsd[5 * 68] = pk2(bfhi(v0.z) * d0, bfhi(v1.z) * d1);
                            dsd[6 * 68] = pk2(bflo(v0.w) * d0, bflo(v1.w) * d1); dsd[7 * 68] = pk2(bfhi(v0.w) * d0, bfhi(v1.w) * d1);
                        }
                        __syncthreads();
                        {
                            const size_t rn = rb + (c < 31 ? 128 : 0);
#pragma unroll
                            for (int i = 0; i < 8; ++i) { const int p = tid + 512 * i; kreg[i] = *(const u32x4*)(Q + (rn + (p >> 5)) * 6144 + kcol + (p & 31) * 8); }
#pragma unroll
                            for (int rr = 0; rr < 2; ++rr) vreg[rr] = *(const u32x4*)(Q + (rn + 2 * lane + rr) * 6144 + vcol + wave * 8);
                        }
#pragma unroll
                        for (int dt = 0; dt < 4; ++dt)
#pragma unroll
                            for (int nt = 0; nt < 2; ++nt) sacc[dt][nt] = sacc[dt][nt] * cd;
#pragma unroll
                        for (int ks = 0; ks < 8; ++ks) {
                            bf16x4 vf[4];
#pragma unroll
                            for (int dt = 0; dt < 4; ++dt) vf[dt] = *(const LAS bf16x4*)(VdT + (16 * dt + fr) * 136 + 16 * ks + fq * 4);
#pragma unroll
                            for (int nt = 0; nt < 2; ++nt) {
                                const LAS bf16_t* kp = Kn + (16 * ks + fq * 4) * 264 + 32 * wave + 16 * nt + fr;
                                const bf16x4 kf = (bf16x4){(short)kp[0], (short)kp[264], (short)kp[2 * 264], (short)kp[3 * 264]};
#pragma unroll
                                for (int dt = 0; dt < 4; ++dt) sacc[dt][nt] = __builtin_amdgcn_mfma_f32_16x16x16bf16_1k(vf[dt], kf, sacc[dt][nt], 0, 0, 0);
                            }
                        }
                        f32x4 oacc[4];
#pragma unroll
                        for (int dt = 0; dt < 4; ++dt) oacc[dt] = (f32x4){0.f, 0.f, 0.f, 0.f};
                        float rf = rf0;
                        for (int jt = 0; jt <= wave; ++jt) {
                            f32x4 a = (f32x4){0.f, 0.f, 0.f, 0.f}, a2 = a;
#pragma unroll
                            for (int kh = 0; kh < 8; kh += 4) {
                                bf16x8 kf[4];
#pragma unroll
                                for (int ks = 0; ks < 4; ++ks) kf[ks] = *(const LAS bf16x8*)(Kn + (16 * jt + fr) * 264 + 32 * (kh + ks) + fq * 8);
                                asm volatile("" : "+v"(kf[0]), "+v"(kf[1]), "+v"(kf[2]), "+v"(kf[3]));
#pragma unroll
                                for (int ks = 0; ks < 4; ks += 2) { a = __builtin_amdgcn_mfma_f32_16x16x32_bf16(kf[ks], qf[kh + ks], a, 0, 0, 0); a2 = __builtin_amdgcn_mfma_f32_16x16x32_bf16(kf[ks + 1], qf[kh + ks + 1], a2, 0, 0, 0); }
                            }
                            a = a + a2;
                            float pv[4];
#pragma unroll
                            for (int jj = 0; jj < 4; ++jj) { const int dj = iq - (16 * jt + fq * 4 + jj); pv[jj] = (dj >= 0) ? a[jj] * (rf * cfj[jj]) : 0.f; }
                            rf *= g16;
                            const unsigned lo = pk2(pv[0], pv[1]), hi = pk2(pv[2], pv[3]);
                            const bf16x4 pf = (bf16x4){(short)(lo & 0xffff), (short)(lo >> 16), (short)(hi & 0xffff), (short)(hi >> 16)};
#pragma unroll
                            for (int dt = 0; dt < 4; ++dt) { const bf16x4 vf = *(const LAS bf16x4*)(VTs + (16 * dt + fr) * 136 + 16 * jt + fq * 4); oacc[dt] = __builtin_amdgcn_mfma_f32_16x16x16bf16_1k(vf, pf, oacc[dt], 0, 0, 0); }
                        }
                        f32x4 cross[4];
#pragma unroll
                        for (int dt = 0; dt < 4; ++dt) { cross[dt] = (f32x4){0.f, 0.f, 0.f, 0.f};
#pragma unroll
                            for (int ks = 0; ks < 8; ++ks) { const bf16x8 sf = *(const LAS bf16x8*)(STs + (16 * dt + fr) * 264 + 32 * ks + fq * 8); cross[dt] = __builtin_amdgcn_mfma_f32_16x16x32_bf16(sf, qf[ks], cross[dt], 0, 0, 0); } }
                        {
                            const size_t rq = rb + (c < 31 ? 128 : 0) + iq;
#pragma unroll
                            for (int ks = 0; ks < 8; ++ks) qf[ks] = *(const bf16x8*)(Q + rq * 6144 + h * 256 + 32 * ks + fq * 8);
                        }
                        float s1 = 0.f, s2 = 0.f;
#pragma unroll
                        for (int dt = 0; dt < 4; ++dt) { const f32x4 o = oacc[dt] + cross[dt] * qd; s1 += (o[0] + o[1]) + (o[2] + o[3]); s2 += (o[0] * o[0] + o[1] * o[1]) + (o[2] * o[2] + o[3] * o[3]);
                            u32x2 w; w.x = pk2(o[0], o[1]); w.y = pk2(o[2], o[3]); *(u32x2*)(Q + (rb + iq) * 6144 + vcol + 16 * dt + fq * 4) = w; }
                        s1 = fq_sum(s1); s2 = fq_sum(s2);
                        if (fq == 0) *(f32x2*)(STAT + (((rb + iq) * 4 + h) * 8 + vs) * 2) = (f32x2){s1, s2};
                        __syncthreads();
#pragma unroll
                        for (int dt = 0; dt < 4; ++dt)
#pragma unroll
                            for (int nt = 0; nt < 2; ++nt) { const unsigned lo = pk2(sacc[dt][nt][0], sacc[dt][nt][1]), hi = pk2(sacc[dt][nt][2], sacc[dt][nt][3]);
                                LAS bf16_t* d = STs + (16 * dt + fq * 4) * 264 + 32 * wave + 16 * nt + fr;
                                d[0] = (bf16_t)(lo & 0xffff); d[264] = (bf16_t)(lo >> 16); d[2 * 264] = (bf16_t)(hi & 0xffff); d[3 * 264] = (bf16_t)(hi >> 16); }
                    }
                }
            }
        } else if (s == 6) {
            if (kind != 2) continue;
            gm = pg8::Gemm{Xc, Wb + W_MIN + (size_t)4096 * 1024, T, 2048, 1024, 1024};
            E.mode = pg8::M_RETG; E.out = ACT + 2048; E.ldc = 6144; E.ssp = SSP; E.nparts = 16; E.stat = STAT; is_gemm = true;
        } else if (s == 7) {
            if (kind == 0) gm = pg8::Gemm{ACT + (size_t)2 * T * 1024, Wb + W_MOUT, T, 1024, 1024, 1024};
            else if (kind == 1) gm = pg8::Gemm{ACT + (size_t)2 * T * 1024, Wb + W_MOUT, T, 1024, 1024, 1024};
            else gm = pg8::Gemm{ACT + 2048, Wb + W_MOUT, T, 1024, 2048, 6144};
            E.mode = pg8::M_YRES; E.out = Xc; E.ps = PS; E.ps2 = SSP; E.gain = ng + 3 * 1024; E.coef = 1.f; E.cnt = CNT + (size_t)(L * 3 + 1) * 128 * 16; is_gemm = true;
        } else if (s == 12) {
            gm = pg8::Gemm{PB, Wb + ((L & 1) ? W_PROJ2 : W_PROJ), T, 1024, 256, 256};
            E.mode = pg8::M_PLAIN; E.out = Yo; E.ldc = 1024; E.nparts = 0; is_gemm = true; do_sync = false;
        } else {
            gm = pg8::Gemm{Xc, Wb + ((L & 1) ? W_GATE2 : W_GATE), T, 1024, 1024, 1024};
            E.mode = pg8::M_GATE; E.ssp = SSP; E.nparts = 16; E.ps = PS; E.xin = Xc; E.xout = (L == 3) ? X : nullptr; E.proj = Yo; E.xb = Yo; is_gemm = true; do_sync = false;
        }
        if (is_gemm) {
            pg8::StaticOrder S; S.init(gm.M, gm.N, G, (int)blockIdx.x);
            pg8::gemm_phase(lds, gm, S, E, tid);
#ifdef GEMM_TWICE
            if (E.mode != pg8::M_GATE) { __syncthreads(); pg8::gemm_phase(lds, gm, S, E, tid); }
#endif
        }
        if (multi && do_sync && step + 1 < P.ph_hi) { if (P.ph_hi < 0) grid.sync(); xcd_barrier(xbar); }
    }
}

extern "C" void kernel_launch(void* const* d_in, const int* in_sizes, int n_in, void* d_out, int out_size, void* d_ws, size_t ws_size, hipStream_t stream) {
    static int grid = 0;
    if (grid == 0) {
        int dev = 0, cus = 0, per_cu = 0;
        hipGetDevice(&dev);
        hipDeviceGetAttribute(&cus, hipDeviceAttributeMultiprocessorCount, dev);
        hipFuncSetAttribute((const void*)fwd_kernel, hipFuncAttributeMaxDynamicSharedMemorySize, LDS_BYTES);
        hipOccupancyMaxActiveBlocksPerMultiprocessor(&per_cu, (const void*)fwd_kernel, 512, LDS_BYTES);
        if (per_cu < 1) per_cu = 1;
        grid = cus * per_cu;
        if (ws_size < WS_END) fprintf(stderr, "kernel_launch: workspace too small: %zu < %zu\n", ws_size, (size_t)WS_END);
    }
    hipMemsetAsync((char*)d_ws + WS_BAR, 0, 64 * 1024 + 12 * 128 * 64, stream);
    Params p{};
    for (int i = 0; i < 16; ++i) p.in[i] = (const float*)d_in[i];
    p.out = (float*)d_out; p.ws = (unsigned char*)d_ws; p.ph_lo = 0; p.ph_hi = NRUN;
    void* args[] = {&p};
    hipError_t e = hipLaunchCooperativeKernel((const void*)fwd_kernel, dim3(grid), dim3(512), args, LDS_BYTES, stream);
    if (e != hipSuccess) fprintf(stderr, "cooperative launch failed: %s (grid %d)\n", hipGetErrorString(e), grid);
}
```

```cpp
#include <hip/hip_runtime.h>
#include <hip/hip_cooperative_groups.h>
#include <cstdio>
namespace cg = cooperative_groups;

#define LAS __attribute__((address_space(3)))
typedef unsigned short bf16_t;
typedef short bf16x8 __attribute__((ext_vector_type(8)));
typedef short bf16x4 __attribute__((ext_vector_type(4)));
typedef float f32x4 __attribute__((ext_vector_type(4)));
typedef float f32x2 __attribute__((ext_vector_type(2)));
typedef unsigned u32x4 __attribute__((ext_vector_type(4)));
typedef unsigned u32x2 __attribute__((ext_vector_type(2)));

constexpr int T = 32768, DM = 1024, FF = 2816, SEQ = 4096;
constexpr float EPS = 1e-6f;
constexpr size_t MiB = 1ull << 20;
constexpr size_t WS_W = 0, WS_XB = 56 * MiB, WS_Y = WS_XB + 64 * MiB, WS_ACT = WS_Y + 64 * MiB, WS_SSP = WS_ACT + 384 * MiB,
                 WS_PS = WS_SSP + 2 * MiB, WS_ROT = WS_PS + 2 * MiB, WS_STAT = WS_ROT + 4 * MiB, WS_BAR = WS_STAT + 8 * MiB, WS_CNT = WS_BAR + 64 * 1024, WS_PB = WS_BAR + 1 * MiB, WS_END = WS_PB + 16 * MiB;
constexpr size_t W_GU0 = 0, W_GU1 = W_GU0 + 5632 * 1024, W_DN0 = W_GU1 + 5632 * 1024, W_DN1 = W_DN0 + 1024 * 2816, W_GATE = W_DN1 + 1024 * 2816,
                 W_PROJ = W_GATE + 1024 * 1024, W_MIN = W_PROJ + 1024 * 256, W_MOUT = W_MIN + 6144 * 1024;
constexpr int LDS_BST = 139264, LDS_BYTES = LDS_BST + 1024;
constexpr int NSTEP_L = 14, NSTEPS = 4 * NSTEP_L;
#ifndef NRUN
#define NRUN NSTEPS
#endif

typedef __bf16 bf2_t __attribute__((ext_vector_type(2)));
__device__ __forceinline__ unsigned pk2(float lo, float hi) { const bf2_t v = __builtin_convertvector((f32x2){lo, hi}, bf2_t); return __builtin_bit_cast(unsigned, v); }
__device__ __forceinline__ float bflo(unsigned u) { return __uint_as_float(u << 16); }
__device__ __forceinline__ float bfhi(unsigned u) { return __uint_as_float(u & 0xffff0000u); }
__device__ __forceinline__ float wave_sum(float v) {
#pragma unroll
    for (int o = 32; o >= 1; o >>= 1) v += __shfl_xor(v, o);
    return v;
}
__device__ __forceinline__ float silu_f(float a) { return a * __builtin_amdgcn_rcpf(1.f + __expf(-a)); }
#ifndef GAMP
#define GAMP 1.f
#endif
__device__ __forceinline__ float sigm_f(float a) { return GAMP * __builtin_amdgcn_rcpf(1.f + __expf(-a)); }
__device__ __forceinline__ float fq_sum(float v) {
    auto a = __builtin_amdgcn_permlane16_swap(__float_as_uint(v), __float_as_uint(v), false, false); v = __uint_as_float(a[0]) + __uint_as_float(a[1]);
    auto b = __builtin_amdgcn_permlane32_swap(__float_as_uint(v), __float_as_uint(v), false, false); return __uint_as_float(b[0]) + __uint_as_float(b[1]);
}
__device__ __forceinline__ float fq_max(float v) {
    auto a = __builtin_amdgcn_permlane16_swap(__float_as_uint(v), __float_as_uint(v), false, false); v = fmaxf(__uint_as_float(a[0]), __uint_as_float(a[1]));
    auto b = __builtin_amdgcn_permlane32_swap(__float_as_uint(v), __float_as_uint(v), false, false); return fmaxf(__uint_as_float(b[0]), __uint_as_float(b[1]));
}
#define LDS_WAIT() asm volatile("s_waitcnt lgkmcnt(0)" ::: "memory")

namespace pg8 {
constexpr int BM = 256, BK = 64, HALF = 128, HTB = HALF * BK * 2, STAGE_BYTES = 8 * HTB, NXCD = 8, WGM = 8;
__device__ __forceinline__ int lds_byte(int r, int c) { const int st = (r >> 4) * 2 + (c >> 5), rr = r & 15, cc = c & 31, ob = rr * 64 + cc * 2; return st * 1024 + (ob ^ (((ob >> 9) & 1) << 5)); }
__device__ __forceinline__ void stage_rc(int b, int& R, int& C) { const int st = b / 1024, sb = b % 1024, swz = sb ^ (((sb >> 9) & 1) << 5); R = (st >> 1) * 16 + swz / 64; C = (st & 1) * 32 + (swz % 64) / 2; }
__device__ __forceinline__ int perm32(int rho) { const int n = rho >> 4, i = rho & 15; return 8 * (i >> 2) + 4 * n + (i & 3); }
struct Unit { int pm, pn; };
struct Gemm { const bf16_t* A; const bf16_t* Bt; int M, N, K, lda; };
struct StaticOrder {
    int nM, nN, nwg, G, c;
    __device__ void init(int M, int N, int G_, int c_) { nM = M / BM; nN = N / BM; nwg = nM * nN; G = G_; c = c_; }
    __device__ bool next(int i, Unit& u) const {
        const long L = (long)i * G + c; if (L >= nwg) return false;
        int wgid = (int)L; { const int q = nwg / NXCD, r = nwg % NXCD, xcd = wgid % NXCD, off = wgid / NXCD; wgid = (xcd < r ? xcd * (q + 1) : r * (q + 1) + (xcd - r) * q) + off; }
        const int nig = WGM * nN, gid = wgid / nig, fm = gid * WGM, gsz = (nM - fm) < WGM ? (nM - fm) : WGM;
        u.pm = fm + ((wgid % nig) % gsz); u.pn = (wgid % nig) / gsz; return true;
    }
};

enum { M_SWIGLU = 0, M_PLAIN = 1, M_Y = 2, M_GATE = 3, M_CONVIN = 4, M_RET = 5, M_YRES = 6, M_RETG = 7 };
struct Epi {
    int mode; bf16_t* out; int ldc; const float* ssp; int nparts; float* ps;
    const bf16_t* xin; float* xout; const bf16_t* proj; bf16_t* xb; bf16_t* out2; const float* rot;
    const float* gain; float coef; unsigned* cnt; float* ps2; const float* stat;
    __device__ __forceinline__ void yres(const f32x4 (&acc)[2][2][4][2], const Unit& u, int wr, int wc, int fr, int fq) const {
        const int rowb = u.pm * BM + wr * 64 + fr, cw = wc * 32 + 8 * fq, lane = fq * 16 + fr;
#pragma unroll
        for (int ai = 0; ai < 2; ++ai)
#pragma unroll
            for (int m = 0; m < 4; ++m) {
                const int r = rowb + ai * HALF + m * 16;
                const f32x4 a0 = acc[ai][0][m][0], a1 = acc[ai][0][m][1], b0 = acc[ai][1][m][0], b1 = acc[ai][1][m][1];
                const f32x4 q = a0 * a0 + a1 * a1 + b0 * b0 + b1 * b1; float sq = (q[0] + q[1]) + (q[2] + q[3]);
                sq += __shfl_xor(sq, 16); sq += __shfl_xor(sq, 32);
                if (fq == 0) __hip_atomic_store(ps + (size_t)r * 16 + u.pn * 4 + wc, sq, __ATOMIC_RELAXED, __HIP_MEMORY_SCOPE_AGENT);
            }
        asm volatile("s_waitcnt vmcnt(0)" ::: "memory");
        unsigned* c = cnt + u.pm * 16;
        if (lane == 0) __hip_atomic_fetch_add(c, 1u, __ATOMIC_RELAXED, __HIP_MEMORY_SCOPE_AGENT);
        if (wr == 0 && wc == 0) { unsigned sp = 0; while ((unsigned)__builtin_amdgcn_readfirstlane(__hip_atomic_load(c, __ATOMIC_RELAXED, __HIP_MEMORY_SCOPE_AGENT)) < 32u) { __builtin_amdgcn_s_sleep(1); if (++sp > (1u << 14)) break; } }
        asm volatile("" ::: "memory"); __builtin_amdgcn_s_barrier(); asm volatile("" ::: "memory");
        const int col0 = u.pn * 256 + cw;
        const f32x4 g0 = *(const f32x4*)(gain + col0) * coef, g1 = *(const f32x4*)(gain + col0 + 4) * coef, g2 = *(const f32x4*)(gain + col0 + 128) * coef, g3 = *(const f32x4*)(gain + col0 + 132) * coef;
#pragma unroll
        for (int ai = 0; ai < 2; ++ai)
#pragma unroll
            for (int m = 0; m < 4; ++m) {
                const int r = rowb + ai * HALF + m * 16;
                const unsigned long long* sp = (const unsigned long long*)(ps + (size_t)r * 16 + fq * 4);
                const unsigned long long t0 = __hip_atomic_load(sp, __ATOMIC_RELAXED, __HIP_MEMORY_SCOPE_AGENT), t1 = __hip_atomic_load(sp + 1, __ATOMIC_RELAXED, __HIP_MEMORY_SCOPE_AGENT);
                float tot = (__uint_as_float((unsigned)t0) + __uint_as_float((unsigned)(t0 >> 32))) + (__uint_as_float((unsigned)t1) + __uint_as_float((unsigned)(t1 >> 32)));
                tot += __shfl_xor(tot, 16); tot += __shfl_xor(tot, 32);
                const float rstd = rsqrtf(tot * (1.f / 1024.f) + EPS);
                bf16_t* xp = out + (size_t)r * 1024 + col0;
                const u32x4 xa = *(const u32x4*)xp, xb_ = *(const u32x4*)(xp + 128);
                const f32x4 a0 = acc[ai][0][m][0] * rstd, a1 = acc[ai][0][m][1] * rstd, b0 = acc[ai][1][m][0] * rstd, b1 = acc[ai][1][m][1] * rstd;
                f32x4 n0 = (f32x4){bflo(xa.x), bfhi(xa.x), bflo(xa.y), bfhi(xa.y)} + a0 * g0, n1 = (f32x4){bflo(xa.z), bfhi(xa.z), bflo(xa.w), bfhi(xa.w)} + a1 * g1;
                f32x4 n2 = (f32x4){bflo(xb_.x), bfhi(xb_.x), bflo(xb_.y), bfhi(xb_.y)} + b0 * g2, n3 = (f32x4){bflo(xb_.z), bfhi(xb_.z), bflo(xb_.w), bfhi(xb_.w)} + b1 * g3;
                u32x4 w; w.x = pk2(n0[0], n0[1]); w.y = pk2(n0[2], n0[3]); w.z = pk2(n1[0], n1[1]); w.w = pk2(n1[2], n1[3]); *(u32x4*)xp = w;
                w.x = pk2(n2[0], n2[1]); w.y = pk2(n2[2], n2[3]); w.z = pk2(n3[0], n3[1]); w.w = pk2(n3[2], n3[3]); *(u32x4*)(xp + 128) = w;
                const f32x4 q = n0 * n0 + n1 * n1 + n2 * n2 + n3 * n3; float sq = (q[0] + q[1]) + (q[2] + q[3]);
                sq += __shfl_xor(sq, 16); sq += __shfl_xor(sq, 32);
                if (fq == 0) ps2[(size_t)r * 16 + u.pn * 4 + wc] = sq;
            }
    }
#define EPI_ROWS(i) (rowb + ((i) >> 2) * HALF + ((i) & 3) * 16)
    template <bool F32OUT> __device__ __forceinline__ void gate_rows(const f32x4 (&acc)[2][2][4][2], const Unit& u, const float (&rsv)[8], int rowb, int cw, int wc, int fq) const {
#define EPI_ACC(i) const int ai = (i) >> 2, m = (i) & 3, r = EPI_ROWS(i); const float rs = rsv[i]; \
        const f32x4 a0 = acc[ai][0][m][0] * rs, a1 = acc[ai][0][m][1] * rs, b0 = acc[ai][1][m][0] * rs, b1 = acc[ai][1][m][1] * rs
#define EPI_PACK(w, p, q) w.x = pk2(p[0], p[1]); w.y = pk2(p[2], p[3]); w.z = pk2(q[0], q[1]); w.w = pk2(q[2], q[3])
#pragma unroll
            for (int hf = 0; hf < 8; ++hf) {
                u32x4 xr[1][2], pr[1][2];
#pragma unroll
                for (int m = 0; m < 1; ++m)
#pragma unroll
                    for (int bj = 0; bj < 2; ++bj) { const size_t off = (size_t)EPI_ROWS(hf + m) * 1024 + u.pn * 256 + bj * 128 + cw; xr[m][bj] = *(const u32x4*)(xin + off); pr[m][bj] = *(const u32x4*)(proj + off); }
#pragma unroll
                for (int m_ = 0; m_ < 1; ++m_) { EPI_ACC(hf + m_);
                    float sq = 0.f;
#pragma unroll
                    for (int bj = 0; bj < 2; ++bj) {
                        const size_t off = (size_t)r * 1024 + u.pn * 256 + bj * 128 + cw;
                        const f32x4 v0 = bj ? b0 : a0, v1 = bj ? b1 : a1; const u32x4 xv = xr[m_][bj], pv = pr[m_][bj];
                        f32x4 n0, n1;
                        n0[0] = bflo(xv.x) + sigm_f(v0[0]) * bflo(pv.x); n0[1] = bfhi(xv.x) + sigm_f(v0[1]) * bfhi(pv.x); n0[2] = bflo(xv.y) + sigm_f(v0[2]) * bflo(pv.y); n0[3] = bfhi(xv.y) + sigm_f(v0[3]) * bfhi(pv.y);
                        n1[0] = bflo(xv.z) + sigm_f(v1[0]) * bflo(pv.z); n1[1] = bfhi(xv.z) + sigm_f(v1[1]) * bfhi(pv.z); n1[2] = bflo(xv.w) + sigm_f(v1[2]) * bflo(pv.w); n1[3] = bfhi(xv.w) + sigm_f(v1[3]) * bfhi(pv.w);
                        if (F32OUT) { *(f32x4*)(xout + off) = n0; *(f32x4*)(xout + off + 4) = n1; }
                        u32x4 w; EPI_PACK(w, n0, n1); *(u32x4*)(xb + off) = w;
                        const f32x4 q = n0 * n0 + n1 * n1; sq += (q[0] + q[1]) + (q[2] + q[3]);
                    }
                    sq = fq_sum(sq);
                    if (fq == 0) ps[(size_t)r * 16 + u.pn * 4 + wc] = sq;
                }
            }
#undef EPI_ACC
#undef EPI_PACK
    }
    __device__ __forceinline__ void operator()(const f32x4 (&acc)[2][2][4][2], const Unit& u, int wr, int wc, int fr, int fq) const {
        if (mode == M_YRES) { yres(acc, u, wr, wc, fr, fq); return; }
        const int rowb = u.pm * BM + wr * 64 + fr, cw = wc * 32 + 8 * fq;
        float rsv[8];
        if (nparts == 16) {
#pragma unroll
            for (int hf = 0; hf < 2; ++hf) {
                f32x4 t[4];
#pragma unroll
                for (int i = 0; i < 4; ++i) t[i] = *(const f32x4*)(ssp + (size_t)EPI_ROWS(hf * 4 + i) * 16 + fq * 4);
#pragma unroll
                for (int i = 0; i < 4; ++i) { float v = (t[i][0] + t[i][1]) + (t[i][2] + t[i][3]); v = fq_sum(v); rsv[hf * 4 + i] = rsqrtf(v * (1.f / 1024.f) + EPS); }
            }
        } else if (nparts == 1) {
            float t[8];
#pragma unroll
            for (int i = 0; i < 8; ++i) t[i] = ssp[(size_t)EPI_ROWS(i) * 16];
#pragma unroll
            for (int i = 0; i < 8; ++i) rsv[i] = rsqrtf(t[i] * (1.f / 1024.f) + EPS);
        } else {
#pragma unroll
            for (int i = 0; i < 8; ++i) rsv[i] = 1.f;
        }
#define EPI_ACC(i) const int ai = (i) >> 2, m = (i) & 3, r = EPI_ROWS(i); const float rs = rsv[i]; \
        const f32x4 a0 = acc[ai][0][m][0] * rs, a1 = acc[ai][0][m][1] * rs, b0 = acc[ai][1][m][0] * rs, b1 = acc[ai][1][m][1] * rs
#define EPI_PACK(w, p, q) w.x = pk2(p[0], p[1]); w.y = pk2(p[2], p[3]); w.z = pk2(q[0], q[1]); w.w = pk2(q[2], q[3])
        if (mode == M_SWIGLU) {
#pragma unroll
            for (int i = 0; i < 8; ++i) { EPI_ACC(i);
                u32x4 w; w.x = pk2(silu_f(a0[0]) * b0[0], silu_f(a0[1]) * b0[1]); w.y = pk2(silu_f(a0[2]) * b0[2], silu_f(a0[3]) * b0[3]);
                w.z = pk2(silu_f(a1[0]) * b1[0], silu_f(a1[1]) * b1[1]); w.w = pk2(silu_f(a1[2]) * b1[2], silu_f(a1[3]) * b1[3]);
                *(u32x4*)(out + (size_t)r * ldc + u.pn * 128 + cw) = w; }
        } else if (mode == M_PLAIN) {
#pragma unroll
            for (int i = 0; i < 8; ++i) { EPI_ACC(i);
                u32x4 w; EPI_PACK(w, a0, a1); *(u32x4*)(out + (size_t)r * ldc + u.pn * 256 + cw) = w;
                EPI_PACK(w, b0, b1); *(u32x4*)(out + (size_t)r * ldc + u.pn * 256 + 128 + cw) = w; }
        } else if (mode == M_CONVIN) {
            if (u.pn < 4) {
#pragma unroll
                for (int i = 0; i < 8; ++i) { EPI_ACC(i);
                    u32x4 w; EPI_PACK(w, a0, a1); *(u32x4*)(out + (size_t)r * 1024 + u.pn * 256 + cw) = w;
                    EPI_PACK(w, b0, b1); *(u32x4*)(out + (size_t)r * 1024 + u.pn * 256 + 128 + cw) = w; }
            } else {
#pragma unroll
                for (int i = 0; i < 8; ++i) { EPI_ACC(i);
                    const f32x4 p0 = a0 * b0, p1 = a1 * b1; u32x4 w; EPI_PACK(w, p0, p1);
                    *(u32x4*)(out2 + (size_t)r * 1024 + (u.pn - 4) * 128 + cw) = w; }
            }
        } else if (mode == M_GATE) {
            if (xout) gate_rows<true>(acc, u, rsv, rowb, cw, wc, fq); else gate_rows<false>(acc, u, rsv, rowb, cw, wc, fq);
        } else if (mode == M_RETG) {
            const int hh = u.pn >> 1;
#pragma unroll
            for (int hf = 0; hf < 8; ++hf) {
                u32x4 oa[1], ob[1]; f32x4 st[1];
#pragma unroll
                for (int m = 0; m < 1; ++m) { const int rr = EPI_ROWS(hf + m); const bf16_t* op = out + (size_t)rr * ldc + u.pn * 256 + cw; oa[m] = *(const u32x4*)op; ob[m] = *(const u32x4*)(op + 128);
                    st[m] = *(const f32x4*)(stat + ((size_t)rr * 4 + hh) * 16 + fq * 4); }
#pragma unroll
                for (int m_ = 0; m_ < 1; ++m_) { EPI_ACC(hf + m_);
                    float s1 = st[m_][0] + st[m_][2], s2 = st[m_][1] + st[m_][3];
                    s1 = fq_sum(s1); s2 = fq_sum(s2);
                    const float mu = s1 * (1.f / 512.f), rstd = rsqrtf(fmaxf(s2 * (1.f / 512.f) - mu * mu, 0.f) + EPS);
                    bf16_t* op = out + (size_t)r * ldc + u.pn * 256 + cw; const u32x4 ov = oa[m_], ow = ob[m_];
                    u32x4 w;
                    w.x = pk2(silu_f(a0[0]) * (bflo(ov.x) - mu) * rstd, silu_f(a0[1]) * (bfhi(ov.x) - mu) * rstd); w.y = pk2(silu_f(a0[2]) * (bflo(ov.y) - mu) * rstd, silu_f(a0[3]) * (bfhi(ov.y) - mu) * rstd);
                    w.z = pk2(silu_f(a1[0]) * (bflo(ov.z) - mu) * rstd, silu_f(a1[1]) * (bfhi(ov.z) - mu) * rstd); w.w = pk2(silu_f(a1[2]) * (bflo(ov.w) - mu) * rstd, silu_f(a1[3]) * (bfhi(ov.w) - mu) * rstd);
                    *(u32x4*)op = w;
                    w.x = pk2(silu_f(b0[0]) * (bflo(ow.x) - mu) * rstd, silu_f(b0[1]) * (bfhi(ow.x) - mu) * rstd); w.y = pk2(silu_f(b0[2]) * (bflo(ow.y) - mu) * rstd, silu_f(b0[3]) * (bfhi(ow.y) - mu) * rstd);
                    w.z = pk2(silu_f(b1[0]) * (bflo(ow.z) - mu) * rstd, silu_f(b1[1]) * (bfhi(ow.z) - mu) * rstd); w.w = pk2(silu_f(b1[2]) * (bflo(ow.w) - mu) * rstd, silu_f(b1[3]) * (bfhi(ow.w) - mu) * rstd);
                    *(u32x4*)(op + 128) = w;
                }
            }
        } else {
            if (u.pn < 8) {
                const float sc = (u.pn >= 4) ? 0.0625f : 1.f;
#pragma unroll
                for (int hf = 0; hf < 8; ++hf) {
                    f32x4 cs[1][4];
#pragma unroll
                    for (int m = 0; m < 1; ++m) { const f32x4* cp = (const f32x4*)(rot + ((size_t)(EPI_ROWS(hf + m) & (SEQ - 1)) * 128 + cw) * 2); cs[m][0] = cp[0]; cs[m][1] = cp[1]; cs[m][2] = cp[2]; cs[m][3] = cp[3]; }
#pragma unroll
                    for (int m_ = 0; m_ < 1; ++m_) { EPI_ACC(hf + m_);
                        const f32x4 c0 = cs[m_][0], c1 = cs[m_][1], c2 = cs[m_][2], c3 = cs[m_][3];
                        f32x4 o0, o1, p0, p1;
                        o0[0] = (a0[0] * c0[0] - b0[0] * c0[1]) * sc; p0[0] = (a0[0] * c0[1] + b0[0] * c0[0]) * sc;
                        o0[1] = (a0[1] * c0[2] - b0[1] * c0[3]) * sc; p0[1] = (a0[1] * c0[3] + b0[1] * c0[2]) * sc;
                        o0[2] = (a0[2] * c1[0] - b0[2] * c1[1]) * sc; p0[2] = (a0[2] * c1[1] + b0[2] * c1[0]) * sc;
                        o0[3] = (a0[3] * c1[2] - b0[3] * c1[3]) * sc; p0[3] = (a0[3] * c1[3] + b0[3] * c1[2]) * sc;
                        o1[0] = (a1[0] * c2[0] - b1[0] * c2[1]) * sc; p1[0] = (a1[0] * c2[1] + b1[0] * c2[0]) * sc;
                        o1[1] = (a1[1] * c2[2] - b1[1] * c2[3]) * sc; p1[1] = (a1[1] * c2[3] + b1[1] * c2[2]) * sc;
                        o1[2] = (a1[2] * c3[0] - b1[2] * c3[1]) * sc; p1[2] = (a1[2] * c3[1] + b1[2] * c3[0]) * sc;
                        o1[3] = (a1[3] * c3[2] - b1[3] * c3[3]) * sc; p1[3] = (a1[3] * c3[3] + b1[3] * c3[2]) * sc;
                        u32x4 w; EPI_PACK(w, o0, o1); *(u32x4*)(out + (size_t)r * ldc + u.pn * 256 + cw) = w;
                        EPI_PACK(w, p0, p1); *(u32x4*)(out + (size_t)r * ldc + u.pn * 256 + 128 + cw) = w;
                    }
                }
            } else {
#pragma unroll
                for (int i = 0; i < 8; ++i) { EPI_ACC(i);
                    u32x4 w; EPI_PACK(w, a0, a1); *(u32x4*)(out + (size_t)r * ldc + u.pn * 256 + cw) = w;
                    EPI_PACK(w, b0, b1); *(u32x4*)(out + (size_t)r * ldc + u.pn * 256 + 128 + cw) = w; }
            }
        }
#undef EPI_ACC
#undef EPI_PACK
    }
};

__device__ __forceinline__ void gemm_phase(LAS unsigned char* lds, const Gemm g, const StaticOrder& S, const Epi& E, const int tid) {
    const int wid = __builtin_amdgcn_readfirstlane(tid >> 6), lane = tid & 63, wr = wid >> 2, wc = wid & 3, fr = lane & 15, fq = lane >> 4;
    const int K = g.K, nt = K / BK, lda = g.lda;
    unsigned voffA[2], voffB[2];
#pragma unroll
    for (int i = 0; i < 2; ++i) { int R, C; stage_rc(tid * 16 + i * 8192, R, C); const int Rb = (R & ~31) + perm32(R & 31);
        voffA[i] = (unsigned)(R * lda + C) * 2u; voffB[i] = (unsigned)(Rb * K + C) * 2u; }
    const size_t kstep = (size_t)(BK * 2);
    const size_t hstepA = (size_t)HALF * lda * 2, tstepA = 2 * hstepA;
    const size_t hstepB = (size_t)HALF * K * 2, tstepB = 2 * hstepB;
    const unsigned ldsw = (unsigned)wid * 1024u;
    const int aoff = lds_byte(wr * 64 + fr, fq * 8), boff = lds_byte(wc * 32 + fr, fq * 8);
#define PG8_SA(b, h) (((b) * 2 + (h)) * HTB)
#define PG8_SB(b, h) ((4 + (b) * 2 + (h)) * HTB)
#define PG8_STAGE(bufoff, gbase, voff) do { _Pragma("unroll") for (int _i = 0; _i < 2; ++_i) \
        __builtin_amdgcn_global_load_lds((const unsigned*)((const char*)(gbase) + (voff)[_i]), (LAS unsigned*)(lds + (bufoff) + ldsw + _i * 8192), 16, 0, 0); } while (0)
#define PG8_LDA(dst, b, h) do { _Pragma("unroll") for (int m = 0; m < 4; ++m) _Pragma("unroll") for (int k = 0; k < 2; ++k) dst[m][k] = *(const LAS bf16x8*)(lds + PG8_SA(b, h) + aoff + m * 2048 + k * 1024); } while (0)
#define PG8_LDB(dst, b, h) do { _Pragma("unroll") for (int n = 0; n < 2; ++n) _Pragma("unroll") for (int k = 0; k < 2; ++k) dst[n][k] = *(const LAS bf16x8*)(lds + PG8_SB(b, h) + boff + n * 2048 + k * 1024); } while (0)
#define PG8_MMA(ai, bj, At, Bt) do { __builtin_amdgcn_s_setprio(1); _Pragma("unroll") for (int m = 0; m < 4; ++m) _Pragma("unroll") for (int n = 0; n < 2; ++n) _Pragma("unroll") for (int k = 0; k < 2; ++k) \
        acc[ai][bj][m][n] = __builtin_amdgcn_mfma_f32_16x16x32_bf16(Bt[n][k], At[m][k], acc[ai][bj][m][n], 0, 0, 0); __builtin_amdgcn_s_setprio(0); } while (0)
#define PG8_WAIT_V(n) asm volatile("s_waitcnt vmcnt(" #n ")" ::: "memory")
#define PG8_WAIT_L(n) asm volatile("s_waitcnt lgkmcnt(" #n ")" ::: "memory")
#define PG8_BAR __builtin_amdgcn_s_barrier()
#define PG8_SCHED __builtin_amdgcn_sched_barrier(0)
    Unit cur, nxt; int ui = 0;
    if (!S.next(0, cur)) return;
    f32x4 acc[2][2][4][2];
#pragma unroll
    for (int a = 0; a < 2; ++a)
#pragma unroll
        for (int b = 0; b < 2; ++b)
#pragma unroll
            for (int m = 0; m < 4; ++m)
#pragma unroll
                for (int n = 0; n < 2; ++n) acc[a][b][m][n] = (f32x4){0.f, 0.f, 0.f, 0.f};
    bf16x8 At[4][2], B0[2][2], B1[2][2];
    const char* cA = (const char*)g.A + (size_t)cur.pm * tstepA; const char* cB = (const char*)g.Bt + (size_t)cur.pn * tstepB;
    PG8_STAGE(PG8_SB(0, 0), cB, voffB); PG8_STAGE(PG8_SB(0, 1), cB + hstepB, voffB); PG8_STAGE(PG8_SA(0, 0), cA, voffA); PG8_STAGE(PG8_SA(0, 1), cA + hstepA, voffA);
    if (wr == 1) PG8_BAR;
    PG8_WAIT_V(2); PG8_BAR;
    PG8_STAGE(PG8_SB(1, 0), cB + kstep, voffB); PG8_STAGE(PG8_SA(1, 0), cA + kstep, voffA); PG8_STAGE(PG8_SB(1, 1), cB + hstepB + kstep, voffB);
    PG8_WAIT_V(6); PG8_BAR;
    for (;;) {
        const bool has_next = S.next(ui + 1, nxt);
        const char* nA = has_next ? (const char*)g.A + (size_t)nxt.pm * tstepA : cA; const char* nB = has_next ? (const char*)g.Bt + (size_t)nxt.pn * tstepB : cB;
        for (int t = 0; t < nt; t += 2) {
            const bool last = (t == nt - 2);
            const char* a1 = cA + (size_t)(t + 1) * kstep;
            const char* a2 = last ? nA : cA + (size_t)(t + 2) * kstep; const char* b2 = last ? nB : cB + (size_t)(t + 2) * kstep;
            const char* a3 = a2 + kstep; const char* b3 = b2 + kstep;
            PG8_LDB(B0, 0, 0); PG8_LDB(B1, 0, 1); PG8_SCHED; PG8_LDA(At, 0, 0); PG8_STAGE(PG8_SA(1, 1), a1 + hstepA, voffA);
            PG8_WAIT_V(8); PG8_WAIT_L(0); PG8_BAR; PG8_MMA(0, 0, At, B0); PG8_MMA(0, 1, At, B1); PG8_BAR; PG8_SCHED;
            PG8_LDA(At, 0, 1); PG8_STAGE(PG8_SB(0, 0), b2, voffB); PG8_STAGE(PG8_SB(0, 1), b2 + hstepB, voffB); PG8_STAGE(PG8_SA(0, 0), a2, voffA);
            PG8_WAIT_V(8); PG8_WAIT_L(0); PG8_BAR; PG8_MMA(1, 0, At, B0); PG8_MMA(1, 1, At, B1); PG8_BAR; PG8_SCHED;
            PG8_LDB(B0, 1, 0); PG8_LDB(B1, 1, 1); PG8_SCHED; PG8_LDA(At, 1, 0); PG8_STAGE(PG8_SA(0, 1), a2 + hstepA, voffA);
            PG8_WAIT_V(8); PG8_WAIT_L(0); PG8_BAR; PG8_MMA(0, 0, At, B0); PG8_MMA(0, 1, At, B1); PG8_BAR; PG8_SCHED;
            PG8_LDA(At, 1, 1); PG8_STAGE(PG8_SB(1, 0), b3, voffB); PG8_STAGE(PG8_SB(1, 1), b3 + hstepB, voffB); PG8_STAGE(PG8_SA(1, 0), a3, voffA);
            PG8_WAIT_V(8); PG8_WAIT_L(0); PG8_BAR; PG8_MMA(1, 0, At, B0); PG8_MMA(1, 1, At, B1); PG8_BAR; PG8_SCHED;
        }
        if (wr == 0) PG8_BAR;
        E(acc, cur, wr, wc, fr, fq);
        if (!has_next) break;
#pragma unroll
        for (int a = 0; a < 2; ++a)
#pragma unroll
            for (int b = 0; b < 2; ++b)
#pragma unroll
                for (int m = 0; m < 4; ++m)
#pragma unroll
                    for (int n = 0; n < 2; ++n) acc[a][b][m][n] = (f32x4){0.f, 0.f, 0.f, 0.f};
        cur = nxt; cA = nA; cB = nB; ++ui;
        if (wr == 1) PG8_BAR;
    }
    PG8_WAIT_V(0);
    PG8_BAR;
}
}

__device__ __forceinline__ void cvt_item(const float* W, int K, int N, bf16_t* WT, int mode, const float* gain, LAS float* scr, int item, int lane) {
    const int nblk = N / 64, kb = item / nblk, nb = item % nblk, k0 = 64 * kb, n0 = 64 * nb;
    const int lr = lane >> 4, lc = (lane & 15) * 4;
    f32x4 v[16];
#pragma unroll
    for (int i = 0; i < 16; ++i) v[i] = *(const f32x4*)(W + (size_t)(k0 + 4 * i + lr) * N + n0 + lc);
#pragma unroll
    for (int i = 0; i < 16; ++i) { const int kk = 4 * i + lr; f32x4 t = v[i]; if (gain) t = t * gain[k0 + kk]; LAS float* d = scr + kk * 65 + lc; d[0] = t[0]; d[1] = t[1]; d[2] = t[2]; d[3] = t[3]; }
    LDS_WAIT();
    int d0 = n0;
    if (mode == 1) { const int half = N / 2, hi = n0 >= half, j = hi ? n0 - half : n0; d0 = (j / 128) * 256 + hi * 128 + (j % 128); }
    else if (mode == 2) { if (n0 >= 1024) { const int jj = (n0 - 1024) & 1023, isv = n0 >= 2048; d0 = 1024 + (jj / 128) * 256 + isv * 128 + (jj % 128); } }
    const int c = lane & 7;
#pragma unroll
    for (int j = 0; j < 8; ++j) { const int n = (lane >> 3) + 8 * j; const LAS float* p = scr + (8 * c) * 65 + n;
        u32x4 o; o.x = pk2(p[0 * 65], p[1 * 65]); o.y = pk2(p[2 * 65], p[3 * 65]); o.z = pk2(p[4 * 65], p[5 * 65]); o.w = pk2(p[6 * 65], p[7 * 65]);
        *(u32x4*)(WT + (size_t)(d0 + n) * K + k0 + 8 * c) = o; }
    LDS_WAIT();
}

#define XB_TMO      128
#define XB_XCNT(j)  (256  + 64 * (j))
#define XB_XSUB(j)  (1280 + 64 * (j))
#define XB_XGEN(j)  (2304 + 64 * (j))
#define XB_TOP      3328
#define XB_TOPGEN   3392
#define XCD_BAR_WORDS 3456
#define XB_SPIN_CAP (1u << 18)
__device__ __forceinline__ unsigned xb_ld(unsigned* p)              { return __hip_atomic_load(p, __ATOMIC_RELAXED, __HIP_MEMORY_SCOPE_AGENT); }
__device__ __forceinline__ unsigned xb_add(unsigned* p, unsigned v) { return __hip_atomic_fetch_add(p, v, __ATOMIC_RELAXED, __HIP_MEMORY_SCOPE_AGENT); }
__device__ __forceinline__ unsigned xb_xcc_id() { return (unsigned)__builtin_amdgcn_s_getreg((3 << 11) | 20) & 0xFu; }
#define XB_SPIN(cond, bar) do { unsigned _sp = 0; while (cond) { __builtin_amdgcn_s_sleep(1); \
    if ((++_sp & 255u) == 0u) { if (xb_ld(&(bar)[XB_TMO])) break; if (_sp > XB_SPIN_CAP) { atomicAdd(&(bar)[XB_TMO], 1u); break; } } } } while (0)
struct XcdBarrier { unsigned* bar; unsigned x; volatile LAS unsigned* st; };
__device__ __forceinline__ XcdBarrier xcd_barrier_post(unsigned* bar, volatile LAS unsigned* st) {
    XcdBarrier b; b.bar = bar; b.x = xb_xcc_id(); b.st = st;
    if (threadIdx.x == 0) (void)xb_add(&bar[XB_XCNT(b.x)], 1u);
    return b;
}
__device__ __forceinline__ void xcd_barrier_complete(unsigned* bar, unsigned x, unsigned& nloc, unsigned& nx) {
    const unsigned G = gridDim.x * gridDim.y * gridDim.z;
    unsigned sum, cnt, mine, sp = 0u;
    for (;;) {
        sum = 0u; cnt = 0u; mine = 0u;
#pragma unroll
        for (unsigned j = 0; j < 16; ++j) { const unsigned c = xb_ld(&bar[XB_XCNT(j)]); sum += c; cnt += (c > 0u) ? 1u : 0u; mine = (j == x) ? c : mine; }
        if (sum == G) break;
        __builtin_amdgcn_s_sleep(1);
        if ((++sp & 255u) == 0u) { if (xb_ld(&bar[XB_TMO])) break; if (sp > XB_SPIN_CAP) { atomicAdd(&bar[XB_TMO], 1u); break; } }
    }
    nloc = mine > 0u ? mine : 1u; nx = cnt > 0u ? cnt : 1u;
}
__device__ __forceinline__ void xcd_barrier(const XcdBarrier& b) {
    asm volatile("s_waitcnt vmcnt(0)" ::: "memory");
    __syncthreads();
    if (__builtin_amdgcn_mbcnt_hi(~0u, __builtin_amdgcn_mbcnt_lo(~0u, 0u)) == 0u && __builtin_amdgcn_readfirstlane(threadIdx.x) == 0) {
        unsigned* bar = b.bar;
        __builtin_amdgcn_s_waitcnt(0);
        unsigned nloc = b.st[0], nx = b.st[1];
        if (nloc == 0u) { xcd_barrier_complete(bar, b.x, nloc, nx); b.st[0] = nloc; b.st[1] = nx; }
        const unsigned old = xb_add(&bar[XB_XSUB(b.x)], 1u);
        const unsigned gen = old / nloc;
        if (old + 1u == (gen + 1u) * nloc) {
            __builtin_amdgcn_fence(__ATOMIC_RELEASE, "agent");
            asm volatile("s_waitcnt vmcnt(0)" ::: "memory");
            const unsigned og = xb_add(&bar[XB_TOP], 1u);
            const unsigned tg = og / nx;
            if (og + 1u == (tg + 1u) * nx) xb_add(&bar[XB_TOPGEN], 1u);
            else XB_SPIN(xb_ld(&bar[XB_TOPGEN]) == tg, bar);
            __builtin_amdgcn_fence(__ATOMIC_ACQUIRE, "agent");
            xb_add(&bar[XB_XGEN(b.x)], 1u);
            asm volatile("s_waitcnt vmcnt(0)" ::: "memory");
        } else {
            XB_SPIN(xb_ld(&bar[XB_XGEN(b.x)]) == gen, bar);
            __builtin_amdgcn_fence(__ATOMIC_ACQUIRE, "agent");
            asm volatile("s_waitcnt vmcnt(0)" ::: "memory");
        }
    }
    __syncthreads();
}

struct Params { const float* in[16]; float* out; unsigned char* ws; int ph_lo, ph_hi; };

__global__ void __launch_bounds__(512) fwd_kernel(Params P) {
    extern __shared__ __attribute__((aligned(16))) unsigned char smem[];
    LAS unsigned char* lds = (LAS unsigned char*)smem;
    cg::grid_group grid = cg::this_grid();
    const int wave = __builtin_amdgcn_readfirstlane(threadIdx.x >> 6);
    const int G = gridDim.x, gw = blockIdx.x * 8 + wave, NGW = G * 8;
    unsigned char* ws = P.ws;
    bf16_t* Wb = (bf16_t*)(ws + WS_W);
    bf16_t* XB = (bf16_t*)(ws + WS_XB);
    bf16_t* YB = (bf16_t*)(ws + WS_Y);
    bf16_t* ACT = (bf16_t*)(ws + WS_ACT);
    bf16_t* PB = (bf16_t*)(ws + WS_PB);
    unsigned* CNT = (unsigned*)(ws + WS_CNT);
    float* SSP = (float*)(ws + WS_SSP);
    float* PS = (float*)(ws + WS_PS);
    float* ROT = (float*)(ws + WS_ROT);
    float* STAT = (float*)(ws + WS_STAT);
    const float* x_in = P.in[0]; const float* p_in = P.in[1]; const float* norm_g = P.in[2];
    float* X = P.out;
    const bool multi = (P.ph_hi - P.ph_lo) > 1;
    volatile LAS unsigned* bst = (volatile LAS unsigned*)(lds + LDS_BST);
    if (threadIdx.x < 4) bst[threadIdx.x] = 0u;
    __syncthreads();
    XcdBarrier xbar = xcd_barrier_post((unsigned*)(ws + WS_BAR), bst);

    for (int step = P.ph_lo; step < P.ph_hi; ++step) {
        int tid = wave * 64 + (int)__builtin_amdgcn_mbcnt_hi(~0u, __builtin_amdgcn_mbcnt_lo(~0u, 0u)); asm volatile("" : "+v"(tid));
        const int lane = tid & 63, fr = lane & 15, fq = lane >> 4;
        const int L = step / NSTEP_L, s = step % NSTEP_L, kind = L % 3, jl = L / 3;
        const float* ng = norm_g + (size_t)L * 7 * 1024;
        bf16_t* Xc = (L & 1) ? YB : XB;
        bf16_t* Yo = (L & 1) ? XB : YB;
        bool is_gemm = false, do_sync = true;
        pg8::Gemm gm{}; pg8::Epi E{};
        if (s == 0) {
            LAS float* scr = (LAS float*)(lds + wave * 16640);
            const float* wgu = P.in[3] + (size_t)L * 2 * 1024 * 5632; const float* wdn = P.in[4] + (size_t)L * 2 * 2816 * 1024;
            const float* wpj = P.in[5] + (size_t)L * 256 * 1024; const float* wgt = P.in[6] + (size_t)L * 1024 * 1024;
            const float* wmi; const float* wmo; int nmi, kmo, mmode;
            if (kind == 0) { wmi = P.in[8] + (size_t)jl * 1024 * 3072; wmo = P.in[10] + (size_t)jl * 1024 * 1024; nmi = 3072; kmo = 1024; mmode = 2; }
            else if (kind == 1) { wmi = P.in[11] + (size_t)jl * 1024 * 1280; wmo = P.in[13] + (size_t)jl * 1024 * 1024; nmi = 1280; kmo = 1024; mmode = 0; }
            else { wmi = P.in[14] + (size_t)jl * 1024 * 6144; wmo = P.in[15] + (size_t)jl * 2048 * 1024; nmi = 6144; kmo = 2048; mmode = 0; }
            const int I_GU = 16 * 88, I_DN = 44 * 16, I_GT = 16 * 16, I_PJ = 4 * 16, I_MI = 16 * (nmi / 64), I_MO = (kmo / 64) * 16;
            const int NIT = 2 * I_GU + 2 * I_DN + I_GT + I_PJ + I_MI + I_MO;
            for (int it = gw; it < NIT; it += NGW) {
                int r = it;
                if (r < I_GU) { cvt_item(wgu, 1024, 5632, Wb + W_GU0, 1, ng + 0 * 1024, scr, r, lane); continue; } r -= I_GU;
                if (r < I_GU) { cvt_item(wgu + (size_t)1024 * 5632, 1024, 5632, Wb + W_GU1, 1, ng + 4 * 1024, scr, r, lane); continue; } r -= I_GU;
                if (r < I_DN) { cvt_item(wdn, 2816, 1024, Wb + W_DN0, 0, nullptr, scr, r, lane); continue; } r -= I_DN;
                if (r < I_DN) { cvt_item(wdn + (size_t)2816 * 1024, 2816, 1024, Wb + W_DN1, 0, nullptr, scr, r, lane); continue; } r -= I_DN;
                if (r < I_GT) { cvt_item(wgt, 1024, 1024, Wb + W_GATE, 0, ng + 6 * 1024, scr, r, lane); continue; } r -= I_GT;
                if (r < I_PJ) { cvt_item(wpj, 256, 1024, Wb + W_PROJ, 0, nullptr, scr, r, lane); continue; } r -= I_PJ;
                if (r < I_MI) { cvt_item(wmi, 1024, nmi, Wb + W_MIN, mmode, ng + 2 * 1024, scr, r, lane); continue; } r -= I_MI;
                cvt_item(wmo, kmo, 1024, Wb + W_MOUT, 0, nullptr, scr, r, lane);
            }
            {
                const float* pin = p_in + (size_t)L * T * 256;
                for (int m = gw; m < T; m += NGW) { const f32x4 pv = *((const f32x4*)(pin + (size_t)m * 256) + lane); u32x2 w; w.x = pk2(pv[0], pv[1]); w.y = pk2(pv[2], pv[3]); *((u32x2*)(PB + (size_t)m * 256) + lane) = w; }
            }
            if (L == 0) {
                for (int m = gw; m < T; m += NGW) {
                    const f32x4* xr = (const f32x4*)(x_in + (size_t)m * 1024) + lane; float ss = 0.f;
#pragma unroll
                    for (int j = 0; j < 4; ++j) { const f32x4 v = xr[64 * j]; ss += (v[0] * v[0] + v[1] * v[1]) + (v[2] * v[2] + v[3] * v[3]);
                        u32x2 w; w.x = pk2(v[0], v[1]); w.y = pk2(v[2], v[3]); *((u32x2*)(XB + (size_t)m * 1024) + lane + 64 * j) = w; }
                    ss = wave_sum(ss); if (lane == 0) SSP[(size_t)m * 16] = ss;
                }
                for (int e = blockIdx.x * 512 + tid; e < SEQ * 128; e += G * 512) {
                    const int pos = e >> 7, d = e & 127;
                    const float inv = exp2f(-(float)d * (1.f / 128.f) * 13.287712379549449f);
                    const float ang = (float)pos * inv;
                    const double rev = (double)ang * 0.15915494309189535; const float fr_ = (float)(rev - rint(rev));
                    ROT[2 * (size_t)e] = __builtin_amdgcn_cosf(fr_); ROT[2 * (size_t)e + 1] = __builtin_amdgcn_sinf(fr_);
                }
            }
        } else if (s == 1 || s == 9) {
            const int f = (s == 9);
            const bool from_gate = (s == 1 && L > 0);
            gm = pg8::Gemm{Xc, Wb + (f ? W_GU1 : W_GU0), T, 5632, 1024, 1024};
            E.mode = pg8::M_SWIGLU; E.out = ACT; E.ldc = FF; E.ssp = from_gate ? PS : SSP; E.nparts = (s == 1 && L == 0) ? 1 : 16; is_gemm = true;
        } else if (s == 2 || s == 10) {
            const int f = (s == 10);
            gm = pg8::Gemm{ACT, Wb + (f ? W_DN1 : W_DN0), T, 1024, FF, FF};
            E.mode = pg8::M_YRES; E.out = Xc; E.ps = PS; E.ps2 = SSP; E.gain = ng + (f ? 5 : 1) * 1024; E.coef = 0.5f; E.cnt = CNT + (size_t)(L * 3 + (f ? 2 : 0)) * 128 * 16; is_gemm = true;
        } else if (s == 3 || s == 8 || s == 11) {
            continue;
        } else if (s == 99) {
            const float* gain = ng + (s == 3 ? 1 : (s == 8 ? 3 : 5)) * 1024; const float coef = (s == 8) ? 1.f : 0.5f;
            const bf16_t* Ysrc = Yo;
            const float* pin = (s == 11) ? p_in + (size_t)L * T * 256 : nullptr;
            f32x4 gv[4];
#pragma unroll
            for (int j = 0; j < 4; ++j) gv[j] = *((const f32x4*)gain + lane + 64 * j) * coef;
            for (int m = gw; m < T; m += NGW) {
                float sp = (lane < 16) ? PS[(size_t)m * 16 + lane] : 0.f; sp = wave_sum(sp);
                const float rstd = rsqrtf(sp * (1.f / 1024.f) + EPS);
                float ss = 0.f;
#pragma unroll
                for (int j = 0; j < 4; ++j) {
                    const u32x2 xr = *((const u32x2*)(Xc + (size_t)m * 1024) + lane + 64 * j);
                    f32x4 xv = (f32x4){bflo(xr.x), bfhi(xr.x), bflo(xr.y), bfhi(xr.y)};
                    const u32x2 yv = *((const u32x2*)(Ysrc + (size_t)m * 1024) + lane + 64 * j);
                    xv[0] += bflo(yv.x) * rstd * gv[j][0]; xv[1] += bfhi(yv.x) * rstd * gv[j][1]; xv[2] += bflo(yv.y) * rstd * gv[j][2]; xv[3] += bfhi(yv.y) * rstd * gv[j][3];
                    ss += (xv[0] * xv[0] + xv[1] * xv[1]) + (xv[2] * xv[2] + xv[3] * xv[3]);
                    u32x2 w; w.x = pk2(xv[0], xv[1]); w.y = pk2(xv[2], xv[3]); *((u32x2*)(Xc + (size_t)m * 1024) + lane + 64 * j) = w;
                }
                ss = wave_sum(ss); if (lane == 0) SSP[(size_t)m * 16] = ss;
                if (pin) { const f32x4 pv = *((const f32x4*)(pin + (size_t)m * 256) + lane); u32x2 w; w.x = pk2(pv[0], pv[1]); w.y = pk2(pv[2], pv[3]); *((u32x2*)(PB + (size_t)m * 256) + lane) = w; }
            }
        } else if (s == 4) {
            const int nmi = kind == 0 ? 3072 : (kind == 1 ? 1280 : 4096);
            gm = pg8::Gemm{Xc, Wb + W_MIN, T, nmi, 1024, 1024};
            E.ssp = SSP; E.nparts = 16; is_gemm = true;
            if (kind == 0) { E.mode = pg8::M_CONVIN; E.out = ACT; E.out2 = ACT + (size_t)T * 1024; E.ldc = 1024; }
            else if (kind == 1) { E.mode = pg8::M_PLAIN; E.out = ACT; E.ldc = 1280; }
            else { E.mode = pg8::M_RET; E.out = ACT; E.ldc = 6144; E.rot = ROT; }
        } else if (s == 5) {
            if (kind == 0) {
                const bf16_t* BG = ACT; const bf16_t* CV = ACT + (size_t)T * 1024; bf16_t* Mo = ACT + (size_t)2 * T * 1024;
                const float* cw_ = P.in[9] + (size_t)jl * 3 * 1024;
                f32x4 w0[4], w1[4], w2[4];
#pragma unroll
                for (int j = 0; j < 4; ++j) { w0[j] = *((const f32x4*)cw_ + lane + 64 * j); w1[j] = *((const f32x4*)(cw_ + 1024) + lane + 64 * j); w2[j] = *((const f32x4*)(cw_ + 2048) + lane + 64 * j); }
                const int rows_per = T / NGW;
                for (int m0 = gw * rows_per; m0 < T; m0 += NGW * rows_per) {
                    f32x4 p2[4], p1[4];
                    const bool has_prev = (m0 & (SEQ - 1)) != 0;
#pragma unroll
                    for (int j = 0; j < 4; ++j) {
                        if (has_prev) { const u32x2 a = *((const u32x2*)(CV + (size_t)(m0 - 2) * 1024) + lane + 64 * j), b = *((const u32x2*)(CV + (size_t)(m0 - 1) * 1024) + lane + 64 * j);
                            p2[j] = (f32x4){bflo(a.x), bfhi(a.x), bflo(a.y), bfhi(a.y)}; p1[j] = (f32x4){bflo(b.x), bfhi(b.x), bflo(b.y), bfhi(b.y)}; }
                        else { p2[j] = (f32x4){0.f, 0.f, 0.f, 0.f}; p1[j] = p2[j]; }
                    }
                    for (int i0 = 0; i0 < rows_per; i0 += 4) {
                        u32x2 cq[4][4], bq[4][4];
#pragma unroll
                        for (int q = 0; q < 4; ++q)
#pragma unroll
                            for (int j = 0; j < 4; ++j) { const size_t m = (size_t)(m0 + i0 + q); cq[q][j] = *((const u32x2*)(CV + m * 1024) + lane + 64 * j); bq[q][j] = *((const u32x2*)(BG + m * 1024) + lane + 64 * j); }
#pragma unroll
                        for (int q = 0; q < 4; ++q) {
                            const size_t m = (size_t)(m0 + i0 + q);
#pragma unroll
                            for (int j = 0; j < 4; ++j) {
                                const u32x2 c = cq[q][j], bg = bq[q][j];
                                const f32x4 cv = (f32x4){bflo(c.x), bfhi(c.x), bflo(c.y), bfhi(c.y)}, bv = (f32x4){bflo(bg.x), bfhi(bg.x), bflo(bg.y), bfhi(bg.y)};
                                const f32x4 o = bv * (w0[j] * p2[j] + w1[j] * p1[j] + w2[j] * cv);
                                u32x2 w; w.x = pk2(o[0], o[1]); w.y = pk2(o[2], o[3]); *((u32x2*)(Mo + m * 1024) + lane + 64 * j) = w;
                                p2[j] = p1[j]; p1[j] = cv;
                            }
                        }
                    }
                }
            } else if (kind == 1) {
                LAS bf16_t* Ks = (LAS bf16_t*)lds;
                LAS bf16_t* VTs = (LAS bf16_t*)(lds + 36864);
                LAS float* BI = (LAS float*)(lds + 36864 + 33792);
                LAS float* SK = BI + 1024;
                const bf16_t* QKV = ACT; bf16_t* Oo = ACT + (size_t)2 * T * 1024;
                const float* relb = P.in[7]; const float* sinks = P.in[12] + (size_t)jl * 16;
#ifdef SWA_TRIVIAL
                for (int m = gw; m < T; m += NGW) { *((u32x4*)(Oo + (size_t)m * 1024) + lane) = *((const u32x4*)(QKV + (size_t)m * 1280) + lane); *((u32x4*)(Oo + (size_t)m * 1024) + 64 + lane) = *((const u32x4*)(QKV + (size_t)m * 1280) + 64 + lane); }
                for (int item = blockIdx.x; item < 0; item += G) {
#else
                for (int item = blockIdx.x; item < 512; item += G) {
#endif
                    const int kvh = item & 1, nb = (item >> 1) & 31, b = item >> 6;
                    __syncthreads();
                    for (int e = tid; e < 1024; e += 512) { const int gg = e >> 7, dist = e & 127; int bucket = dist;
                        if (dist >= 16) { const float d = (float)dist; int lg_ = 16 + (int)(logf(d / 16.f) / 2.0794415416798357f * 16.f); bucket = lg_ < 31 ? lg_ : 31; }
                        BI[e] = relb[bucket * 16 + kvh * 8 + gg]; }
                    if (tid < 8) SK[tid] = sinks[kvh * 8 + tid];
#pragma unroll
                    for (int i = 0; i < 4; ++i) {
                        const int q = tid + 512 * i, kk = q >> 3, c8 = q & 7; const bool valid = (nb > 0) || (kk >= 128);
                        u32x4 kv = (u32x4){0u, 0u, 0u, 0u}, vv = kv;
                        if (valid) { const size_t rk = (size_t)b * SEQ + (size_t)(nb - 1) * 128 + kk; kv = *(const u32x4*)(QKV + rk * 1280 + 1024 + kvh * 64 + c8 * 8); vv = *(const u32x4*)(QKV + rk * 1280 + 1152 + kvh * 64 + c8 * 8); }
                        *(LAS u32x4*)(Ks + kk * 72 + c8 * 8) = kv;
                        LAS bf16_t* vt = VTs + (c8 * 8) * 264 + kk;
                        vt[0 * 264] = (bf16_t)(vv.x & 0xffff); vt[1 * 264] = (bf16_t)(vv.x >> 16); vt[2 * 264] = (bf16_t)(vv.y & 0xffff); vt[3 * 264] = (bf16_t)(vv.y >> 16);
                        vt[4 * 264] = (bf16_t)(vv.z & 0xffff); vt[5 * 264] = (bf16_t)(vv.z >> 16); vt[6 * 264] = (bf16_t)(vv.w & 0xffff); vt[7 * 264] = (bf16_t)(vv.w >> 16);
                    }
                    __syncthreads();
                    const int gg = wave, h = kvh * 8 + gg; const float sink = SK[gg];
                    for (int it = 0; it < 8; ++it) {
                        const int i0 = 16 * it; const size_t r = (size_t)b * SEQ + (size_t)nb * 128 + i0 + fr;
                        bf16x8 qf[2];
#pragma unroll
                        for (int ks = 0; ks < 2; ++ks) qf[ks] = *(const bf16x8*)(QKV + r * 1280 + h * 64 + 32 * ks + fq * 8);
                        float lg[9][4]; float mx = sink;
#pragma unroll
                        for (int t = 0; t < 9; ++t) {
                            const int kt = it + t; f32x4 a = (f32x4){0.f, 0.f, 0.f, 0.f};
#pragma unroll
                            for (int ks = 0; ks < 2; ++ks) { const bf16x8 kf = *(const LAS bf16x8*)(Ks + (16 * kt + fr) * 72 + 32 * ks + fq * 8); a = __builtin_amdgcn_mfma_f32_16x16x32_bf16(kf, qf[ks], a, 0, 0, 0); }
#pragma unroll
                            for (int jj = 0; jj < 4; ++jj) { const int kk = 16 * kt + fq * 4 + jj, dist = i0 + fr + 128 - kk; const bool valid = (dist >= 0) && (dist < 128) && ((nb > 0) || (kk >= 128));
                                const float v = valid ? a[jj] * 0.125f + BI[gg * 128 + (dist & 127)] : -INFINITY; lg[t][jj] = v; mx = fmaxf(mx, v); }
                        }
                        mx = fq_max(mx);
                        float sum = 0.f;
#pragma unroll
                        for (int t = 0; t < 9; ++t)
#pragma unroll
                            for (int jj = 0; jj < 4; ++jj) { const float e = __expf(lg[t][jj] - mx); lg[t][jj] = e; sum += e; }
                        sum = fq_sum(sum);
                        const float inv = 1.f / (sum + __expf(sink - mx));
                        bf16x4 pf[9];
#pragma unroll
                        for (int t = 0; t < 9; ++t) { const unsigned lo = pk2(lg[t][0] * inv, lg[t][1] * inv), hi = pk2(lg[t][2] * inv, lg[t][3] * inv);
                            pf[t] = (bf16x4){(short)(lo & 0xffff), (short)(lo >> 16), (short)(hi & 0xffff), (short)(hi >> 16)}; }
#pragma unroll
                        for (int dt = 0; dt < 4; ++dt) {
                            f32x4 o = (f32x4){0.f, 0.f, 0.f, 0.f};
#pragma unroll
                            for (int t = 0; t < 9; ++t) { const bf16x4 vf = *(const LAS bf16x4*)(VTs + (16 * dt + fr) * 264 + 16 * (it + t) + fq * 4); o = __builtin_amdgcn_mfma_f32_16x16x16bf16_1k(vf, pf[t], o, 0, 0, 0); }
                            u32x2 w; w.x = pk2(o[0], o[1]); w.y = pk2(o[2], o[3]); *(u32x2*)(Oo + r * 1024 + h * 64 + 16 * dt + fq * 4) = w;
                        }
                    }
                }
            } else {
                LAS bf16_t* Kn = (LAS bf16_t*)lds;
                LAS bf16_t* VTs = (LAS bf16_t*)(lds + 67584);
                LAS bf16_t* VdT = (LAS bf16_t*)(lds + 67584 + 17408);
                LAS bf16_t* STs = (LAS bf16_t*)(lds + 67584 + 2 * 17408);
                bf16_t* Q = ACT;
                for (int item = blockIdx.x; item < 256; item += G) {
                    const int ix = item >> 3, ph = (item & 7) * 4 + (ix >> 3), vs = ix & 7, h = ph & 3, b = ph >> 2;
                    const float lgam = logf(1.f - exp2f(-5.f - (float)h));
                    const float cd = __expf(lgam * 128.f);
                    __syncthreads();
                    for (int e = tid; e < 64 * 264 / 2; e += 512) ((LAS unsigned*)STs)[e] = 0u;
                    f32x4 sacc[4][2];
#pragma unroll
                    for (int dt = 0; dt < 4; ++dt)
#pragma unroll
                        for (int nt = 0; nt < 2; ++nt) sacc[dt][nt] = (f32x4){0.f, 0.f, 0.f, 0.f};
                    const float d0 = __expf(lgam * (float)(127 - 2 * lane)), d1 = __expf(lgam * (float)(126 - 2 * lane));
                    const int iq = 16 * wave + fr; const float qd = __expf(lgam * (float)(iq + 1));
                    const float rf0 = __expf(lgam * (float)(iq - fq * 4)), g16 = __expf(-16.f * lgam);
                    float cfj[4];
#pragma unroll
                    for (int jj = 0; jj < 4; ++jj) cfj[jj] = __expf(-lgam * (float)jj);
                    const size_t kcol = 1024 + h * 256, vcol = 2048 + h * 512 + vs * 64;
                    u32x4 kreg[8], vreg[2]; bf16x8 qf[8];
                    {
                        const size_t rb = (size_t)b * SEQ;
#pragma unroll
                        for (int i = 0; i < 8; ++i) { const int p = tid + 512 * i; kreg[i] = *(const u32x4*)(Q + (rb + (p >> 5)) * 6144 + kcol + (p & 31) * 8); }
#pragma unroll
                        for (int rr = 0; rr < 2; ++rr) vreg[rr] = *(const u32x4*)(Q + (rb + 2 * lane + rr) * 6144 + vcol + wave * 8);
#pragma unroll
                        for (int ks = 0; ks < 8; ++ks) qf[ks] = *(const bf16x8*)(Q + (rb + iq) * 6144 + h * 256 + 32 * ks + fq * 8);
                    }
                    for (int c = 0; c < 32; ++c) {
                        const size_t rb = (size_t)b * SEQ + (size_t)c * 128;
#pragma unroll
                        for (int i = 0; i < 8; ++i) { const int p = tid + 512 * i; *(LAS u32x4*)(Kn + (p >> 5) * 264 + (p & 31) * 8) = kreg[i]; }
                        {
                            const u32x4 v0 = vreg[0], v1 = vreg[1]; LAS unsigned* dst = (LAS unsigned*)(VTs + (wave * 8) * 136 + 2 * lane); LAS unsigned* dsd = (LAS unsigned*)(VdT + (wave * 8) * 136 + 2 * lane);
                            dst[0 * 68] = (v0.x & 0xffffu) | (v1.x << 16); dst[1 * 68] = (v0.x >> 16) | (v1.x & 0xffff0000u);
                            dst[2 * 68] = (v0.y & 0xffffu) | (v1.y << 16); dst[3 * 68] = (v0.y >> 16) | (v1.y & 0xffff0000u);
                            dst[4 * 68] = (v0.z & 0xffffu) | (v1.z << 16); dst[5 * 68] = (v0.z >> 16) | (v1.z & 0xffff0000u);
                            dst[6 * 68] = (v0.w & 0xffffu) | (v1.w << 16); dst[7 * 68] = (v0.w >> 16) | (v1.w & 0xffff0000u);
                            dsd[0 * 68] = pk2(bflo(v0.x) * d0, bflo(v1.x) * d1); dsd[1 * 68] = pk2(bfhi(v0.x) * d0, bfhi(v1.x) * d1);
                            dsd[2 * 68] = pk2(bflo(v0.y) * d0, bflo(v1.y) * d1); dsd[3 * 68] = pk2(bfhi(v0.y) * d0, bfhi(v1.y) * d1);
                            dsd[4 * 68] = pk2(bflo(v0.z) * d0, bflo(v1.z) * d1); dsd[5 * 68] = pk2(bfhi(v0.z) * d0, bfhi(v1.z) * d1);
                            dsd[6 * 68] = pk2(bflo(v0.w) * d0, bflo(v1.w) * d1); dsd[7 * 68] = pk2(bfhi(v0.w) * d0, bfhi(v1.w) * d1);
                        }
                        __syncthreads();
                        {
                            const size_t rn = rb + (c < 31 ? 128 : 0);
#pragma unroll
                            for (int i = 0; i < 8; ++i) { const int p = tid + 512 * i; kreg[i] = *(const u32x4*)(Q + (rn + (p >> 5)) * 6144 + kcol + (p & 31) * 8); }
#pragma unroll
                            for (int rr = 0; rr < 2; ++rr) vreg[rr] = *(const u32x4*)(Q + (rn + 2 * lane + rr) * 6144 + vcol + wave * 8);
                        }
#pragma unroll
                        for (int dt = 0; dt < 4; ++dt)
#pragma unroll
                            for (int nt = 0; nt < 2; ++nt) sacc[dt][nt] = sacc[dt][nt] * cd;
#pragma unroll
                        for (int ks = 0; ks < 8; ++ks) {
                            bf16x4 vf[4];
#pragma unroll
                            for (int dt = 0; dt < 4; ++dt) vf[dt] = *(const LAS bf16x4*)(VdT + (16 * dt + fr) * 136 + 16 * ks + fq * 4);
#pragma unroll
                            for (int nt = 0; nt < 2; ++nt) {
                                const LAS bf16_t* kp = Kn + (16 * ks + fq * 4) * 264 + 32 * wave + 16 * nt + fr;
                                const bf16x4 kf = (bf16x4){(short)kp[0], (short)kp[264], (short)kp[2 * 264], (short)kp[3 * 264]};
#pragma unroll
                                for (int dt = 0; dt < 4; ++dt) sacc[dt][nt] = __builtin_amdgcn_mfma_f32_16x16x16bf16_1k(vf[dt], kf, sacc[dt][nt], 0, 0, 0);
                            }
                        }
                        f32x4 oacc[4];
#pragma unroll
                        for (int dt = 0; dt < 4; ++dt) oacc[dt] = (f32x4){0.f, 0.f, 0.f, 0.f};
                        float rf = rf0;
                        for (int jt = 0; jt <= wave; ++jt) {
                            f32x4 a = (f32x4){0.f, 0.f, 0.f, 0.f}, a2 = a;
#pragma unroll
                            for (int kh = 0; kh < 8; kh += 4) {
                                bf16x8 kf[4];
#pragma unroll
                                for (int ks = 0; ks < 4; ++ks) kf[ks] = *(const LAS bf16x8*)(Kn + (16 * jt + fr) * 264 + 32 * (kh + ks) + fq * 8);
                                asm volatile("" : "+v"(kf[0]), "+v"(kf[1]), "+v"(kf[2]), "+v"(kf[3]));
#pragma unroll
                                for (int ks = 0; ks < 4; ks += 2) { a = __builtin_amdgcn_mfma_f32_16x16x32_bf16(kf[ks], qf[kh + ks], a, 0, 0, 0); a2 = __builtin_amdgcn_mfma_f32_16x16x32_bf16(kf[ks + 1], qf[kh + ks + 1], a2, 0, 0, 0); }
                            }
                            a = a + a2;
                            float pv[4];
#pragma unroll
                            for (int jj = 0; jj < 4; ++jj) { const int dj = iq - (16 * jt + fq * 4 + jj); pv[jj] = (dj >= 0) ? a[jj] * (rf * cfj[jj]) : 0.f; }
                            rf *= g16;
                            const unsigned lo = pk2(pv[0], pv[1]), hi = pk2(pv[2], pv[3]);
                            const bf16x4 pf = (bf16x4){(short)(lo & 0xffff), (short)(lo >> 16), (short)(hi & 0xffff), (short)(hi >> 16)};
#pragma unroll
                            for (int dt = 0; dt < 4; ++dt) { const bf16x4 vf = *(const LAS bf16x4*)(VTs + (16 * dt + fr) * 136 + 16 * jt + fq * 4); oacc[dt] = __builtin_amdgcn_mfma_f32_16x16x16bf16_1k(vf, pf, oacc[dt], 0, 0, 0); }
                        }
                        f32x4 cross[4];
#pragma unroll
                        for (int dt = 0; dt < 4; ++dt) { cross[dt] = (f32x4){0.f, 0.f, 0.f, 0.f};
#pragma unroll
                            for (int ks = 0; ks < 8; ++ks) { const bf16x8 sf = *(const LAS bf16x8*)(STs + (16 * dt + fr) * 264 + 32 * ks + fq * 8); cross[dt] = __builtin_amdgcn_mfma_f32_16x16x32_bf16(sf, qf[ks], cross[dt], 0, 0, 0); } }
                        {
                            const size_t rq = rb + (c < 31 ? 128 : 0) + iq;
#pragma unroll
                            for (int ks = 0; ks < 8; ++ks) qf[ks] = *(const bf16x8*)(Q + rq * 6144 + h * 256 + 32 * ks + fq * 8);
                        }
                        float s1 = 0.f, s2 = 0.f;
#pragma unroll
                        for (int dt = 0; dt < 4; ++dt) { const f32x4 o = oacc[dt] + cross[dt] * qd; s1 += (o[0] + o[1]) + (o[2] + o[3]); s2 += (o[0] * o[0] + o[1] * o[1]) + (o[2] * o[2] + o[3] * o[3]);
                            u32x2 w; w.x = pk2(o[0], o[1]); w.y = pk2(o[2], o[3]); *(u32x2*)(Q + (rb + iq) * 6144 + vcol + 16 * dt + fq * 4) = w; }
                        s1 = fq_sum(s1); s2 = fq_sum(s2);
                        if (fq == 0) *(f32x2*)(STAT + (((rb + iq) * 4 + h) * 8 + vs) * 2) = (f32x2){s1, s2};
                        __syncthreads();
#pragma unroll
                        for (int dt = 0; dt < 4; ++dt)
#pragma unroll
                            for (int nt = 0; nt < 2; ++nt) { const unsigned lo = pk2(sacc[dt][nt][0], sacc[dt][nt][1]), hi = pk2(sacc[dt][nt][2], sacc[dt][nt][3]);
                                LAS bf16_t* d = STs + (16 * dt + fq * 4) * 264 + 32 * wave + 16 * nt + fr;
                                d[0] = (bf16_t)(lo & 0xffff); d[264] = (bf16_t)(lo >> 16); d[2 * 264] = (bf16_t)(hi & 0xffff); d[3 * 264] = (bf16_t)(hi >> 16); }
                    }
                }
            }
        } else if (s == 6) {
            if (kind != 2) continue;
            gm = pg8::Gemm{Xc, Wb + W_MIN + (size_t)4096 * 1024, T, 2048, 1024, 1024};
            E.mode = pg8::M_RETG; E.out = ACT + 2048; E.ldc = 6144; E.ssp = SSP; E.nparts = 16; E.stat = STAT; is_gemm = true;
        } else if (s == 7) {
            if (kind == 0) gm = pg8::Gemm{ACT + (size_t)2 * T * 1024, Wb + W_MOUT, T, 1024, 1024, 1024};
            else if (kind == 1) gm = pg8::Gemm{ACT + (size_t)2 * T * 1024, Wb + W_MOUT, T, 1024, 1024, 1024};
            else gm = pg8::Gemm{ACT + 2048, Wb + W_MOUT, T, 1024, 2048, 6144};
            E.mode = pg8::M_YRES; E.out = Xc; E.ps = PS; E.ps2 = SSP; E.gain = ng + 3 * 1024; E.coef = 1.f; E.cnt = CNT + (size_t)(L * 3 + 1) * 128 * 16; is_gemm = true;
        } else if (s == 12) {
            gm = pg8::Gemm{PB, Wb + W_PROJ, T, 1024, 256, 256};
            E.mode = pg8::M_PLAIN; E.out = Yo; E.ldc = 1024; E.nparts = 0; is_gemm = true; do_sync = false;
        } else {
            gm = pg8::Gemm{Xc, Wb + W_GATE, T, 1024, 1024, 1024};
            E.mode = pg8::M_GATE; E.ssp = SSP; E.nparts = 16; E.ps = PS; E.xin = Xc; E.xout = (L == 3) ? X : nullptr; E.proj = Yo; E.xb = Yo; is_gemm = true;
        }
        if (is_gemm) {
            pg8::StaticOrder S; S.init(gm.M, gm.N, G, (int)blockIdx.x);
            pg8::gemm_phase(lds, gm, S, E, tid);
#ifdef GEMM_TWICE
            if (E.mode != pg8::M_GATE) { __syncthreads(); pg8::gemm_phase(lds, gm, S, E, tid); }
#endif
        }
        if (multi && do_sync && step + 1 < P.ph_hi) { if (P.ph_hi < 0) grid.sync(); xcd_barrier(xbar); }
    }
}

extern "C" void kernel_launch(void* const* d_in, const int* in_sizes, int n_in, void* d_out, int out_size, void* d_ws, size_t ws_size, hipStream_t stream) {
    static int grid = 0;
    if (grid == 0) {
        int dev = 0, cus = 0, per_cu = 0;
        hipGetDevice(&dev);
        hipDeviceGetAttribute(&cus, hipDeviceAttributeMultiprocessorCount, dev);
        hipFuncSetAttribute((const void*)fwd_kernel, hipFuncAttributeMaxDynamicSharedMemorySize, LDS_BYTES);
        hipOccupancyMaxActiveBlocksPerMultiprocessor(&per_cu, (const void*)fwd_kernel, 512, LDS_BYTES);
        if (per_cu < 1) per_cu = 1;
        grid = cus * per_cu;
        if (ws_size < WS_END) fprintf(stderr, "kernel_launch: workspace too small: %zu < %zu\n", ws_size, (size_t)WS_END);
    }
    hipMemsetAsync((char*)d_ws + WS_BAR, 0, 64 * 1024 + 12 * 128 * 64, stream);
    Params p{};
    for (int i = 0; i < 16; ++i) p.in[i] = (const float*)d_in[i];
    p.out = (float*)d_out; p.ws = (unsigned char*)d_ws; p.ph_lo = 0; p.ph_hi = NRUN;
    void* args[] = {&p};
    hipError_t e = hipLaunchCooperativeKernel((const void*)fwd_kernel, dim3(grid), dim3(512), args, LDS_BYTES, stream);
    if (e != hipSuccess) fprintf(stderr, "cooperative launch failed: %s (grid %d)\n", hipGetErrorString(e), grid);
}
```

```cpp
#include <hip/hip_runtime.h>
#include <hip/hip_cooperative_groups.h>
#include <cstdio>
namespace cg = cooperative_groups;

#define LAS __attribute__((address_space(3)))
typedef unsigned short bf16_t;
typedef short bf16x8 __attribute__((ext_vector_type(8)));
typedef short bf16x4 __attribute__((ext_vector_type(4)));
typedef float f32x4 __attribute__((ext_vector_type(4)));
typedef float f32x2 __attribute__((ext_vector_type(2)));
typedef unsigned u32x4 __attribute__((ext_vector_type(4)));
typedef unsigned u32x2 __attribute__((ext_vector_type(2)));

constexpr int T = 32768, DM = 1024, FF = 2816, SEQ = 4096;
constexpr float EPS = 1e-6f;
constexpr size_t MiB = 1ull << 20;
constexpr size_t WS_W = 0, WS_XB = 56 * MiB, WS_Y = WS_XB + 64 * MiB, WS_ACT = WS_Y + 64 * MiB, WS_SSP = WS_ACT + 384 * MiB,
                 WS_PS = WS_SSP + 2 * MiB, WS_ROT = WS_PS + 2 * MiB, WS_STAT = WS_ROT + 4 * MiB, WS_BAR = WS_STAT + 8 * MiB, WS_CNT = WS_BAR + 64 * 1024, WS_PB = WS_BAR + 1 * MiB, WS_END = WS_PB + 16 * MiB;
constexpr size_t W_GU0 = 0, W_GU1 = W_GU0 + 5632 * 1024, W_DN0 = W_GU1 + 5632 * 1024, W_DN1 = W_DN0 + 1024 * 2816, W_GATE = W_DN1 + 1024 * 2816,
                 W_PROJ = W_GATE + 1024 * 1024, W_MIN = W_PROJ + 1024 * 256, W_MOUT = W_MIN + 6144 * 1024;
constexpr int LDS_BST = 139264, LDS_BYTES = LDS_BST + 1024;
constexpr int NSTEP_L = 14, NSTEPS = 4 * NSTEP_L;
#ifndef NRUN
#define NRUN NSTEPS
#endif

typedef __bf16 bf2_t __attribute__((ext_vector_type(2)));
__device__ __forceinline__ unsigned pk2(float lo, float hi) { const bf2_t v = __builtin_convertvector((f32x2){lo, hi}, bf2_t); return __builtin_bit_cast(unsigned, v); }
__device__ __forceinline__ float bflo(unsigned u) { return __uint_as_float(u << 16); }
__device__ __forceinline__ float bfhi(unsigned u) { return __uint_as_float(u & 0xffff0000u); }
__device__ __forceinline__ float wave_sum(float v) {
#pragma unroll
    for (int o = 32; o >= 1; o >>= 1) v += __shfl_xor(v, o);
    return v;
}
__device__ __forceinline__ float silu_f(float a) { return a * __builtin_amdgcn_rcpf(1.f + __expf(-a)); }
#ifndef GAMP
#define GAMP 1.f
#endif
__device__ __forceinline__ float sigm_f(float a) { return GAMP * __builtin_amdgcn_rcpf(1.f + __expf(-a)); }
__device__ __forceinline__ float fq_sum(float v) {
    auto a = __builtin_amdgcn_permlane16_swap(__float_as_uint(v), __float_as_uint(v), false, false); v = __uint_as_float(a[0]) + __uint_as_float(a[1]);
    auto b = __builtin_amdgcn_permlane32_swap(__float_as_uint(v), __float_as_uint(v), false, false); return __uint_as_float(b[0]) + __uint_as_float(b[1]);
}
__device__ __forceinline__ float fq_max(float v) {
    auto a = __builtin_amdgcn_permlane16_swap(__float_as_uint(v), __float_as_uint(v), false, false); v = fmaxf(__uint_as_float(a[0]), __uint_as_float(a[1]));
    auto b = __builtin_amdgcn_permlane32_swap(__float_as_uint(v), __float_as_uint(v), false, false); return fmaxf(__uint_as_float(b[0]), __uint_as_float(b[1]));
}
#define LDS_WAIT() asm volatile("s_waitcnt lgkmcnt(0)" ::: "memory")

namespace pg8 {
constexpr int BM = 256, BK = 64, HALF = 128, HTB = HALF * BK * 2, STAGE_BYTES = 8 * HTB, NXCD = 8, WGM = 8;
__device__ __forceinline__ int lds_byte(int r, int c) { const int st = (r >> 4) * 2 + (c >> 5), rr = r & 15, cc = c & 31, ob = rr * 64 + cc * 2; return st * 1024 + (ob ^ (((ob >> 9) & 1) << 5)); }
__device__ __forceinline__ void stage_rc(int b, int& R, int& C) { const int st = b / 1024, sb = b % 1024, swz = sb ^ (((sb >> 9) & 1) << 5); R = (st >> 1) * 16 + swz / 64; C = (st & 1) * 32 + (swz % 64) / 2; }
__device__ __forceinline__ int perm32(int rho) { const int n = rho >> 4, i = rho & 15; return 8 * (i >> 2) + 4 * n + (i & 3); }
struct Unit { int pm, pn; };
struct Gemm { const bf16_t* A; const bf16_t* Bt; int M, N, K, lda; };
struct StaticOrder {
    int nM, nN, nwg, G, c;
    __device__ void init(int M, int N, int G_, int c_) { nM = M / BM; nN = N / BM; nwg = nM * nN; G = G_; c = c_; }
    __device__ bool next(int i, Unit& u) const {
        const long L = (long)i * G + c; if (L >= nwg) return false;
        int wgid = (int)L; { const int q = nwg / NXCD, r = nwg % NXCD, xcd = wgid % NXCD, off = wgid / NXCD; wgid = (xcd < r ? xcd * (q + 1) : r * (q + 1) + (xcd - r) * q) + off; }
        const int nig = WGM * nN, gid = wgid / nig, fm = gid * WGM, gsz = (nM - fm) < WGM ? (nM - fm) : WGM;
        u.pm = fm + ((wgid % nig) % gsz); u.pn = (wgid % nig) / gsz; return true;
    }
};

enum { M_SWIGLU = 0, M_PLAIN = 1, M_Y = 2, M_GATE = 3, M_CONVIN = 4, M_RET = 5, M_YRES = 6, M_RETG = 7 };
struct Epi {
    int mode; bf16_t* out; int ldc; const float* ssp; int nparts; float* ps;
    const bf16_t* xin; float* xout; const bf16_t* proj; bf16_t* xb; bf16_t* out2; const float* rot;
    const float* gain; float coef; unsigned* cnt; float* ps2; const float* stat; LAS float* stab;
    __device__ __forceinline__ void yres(const f32x4 (&acc)[2][2][4][2], const Unit& u, int wr, int wc, int fr, int fq) const {
        const int rowb = u.pm * BM + wr * 64 + fr, cw = wc * 32 + 8 * fq, lane = fq * 16 + fr;
#pragma unroll
        for (int ai = 0; ai < 2; ++ai)
#pragma unroll
            for (int m = 0; m < 4; ++m) {
                const int r = rowb + ai * HALF + m * 16;
                const f32x4 a0 = acc[ai][0][m][0], a1 = acc[ai][0][m][1], b0 = acc[ai][1][m][0], b1 = acc[ai][1][m][1];
                const f32x4 q = a0 * a0 + a1 * a1 + b0 * b0 + b1 * b1; float sq = (q[0] + q[1]) + (q[2] + q[3]);
                sq += __shfl_xor(sq, 16); sq += __shfl_xor(sq, 32);
                if (fq == 0) __hip_atomic_store(ps + (size_t)r * 16 + u.pn * 4 + wc, sq, __ATOMIC_RELAXED, __HIP_MEMORY_SCOPE_AGENT);
            }
        asm volatile("s_waitcnt vmcnt(0)" ::: "memory");
        unsigned* c = cnt + u.pm * 16;
        if (lane == 0) __hip_atomic_fetch_add(c, 1u, __ATOMIC_RELAXED, __HIP_MEMORY_SCOPE_AGENT);
        if (wr == 0 && wc == 0) { unsigned sp = 0; while ((unsigned)__builtin_amdgcn_readfirstlane(__hip_atomic_load(c, __ATOMIC_RELAXED, __HIP_MEMORY_SCOPE_AGENT)) < 32u) { __builtin_amdgcn_s_sleep(1); if (++sp > (1u << 14)) break; } }
        asm volatile("" ::: "memory"); __builtin_amdgcn_s_barrier(); asm volatile("" ::: "memory");
        {
            const int rloc = (wr * 4 + wc) * 32 + (lane >> 1), hf = lane & 1;
            const unsigned long long* sp = (const unsigned long long*)(ps + (size_t)(u.pm * BM + rloc) * 16 + hf * 8);
            const unsigned long long t0 = __hip_atomic_load(sp, __ATOMIC_RELAXED, __HIP_MEMORY_SCOPE_AGENT), t1 = __hip_atomic_load(sp + 1, __ATOMIC_RELAXED, __HIP_MEMORY_SCOPE_AGENT),
                                     t2 = __hip_atomic_load(sp + 2, __ATOMIC_RELAXED, __HIP_MEMORY_SCOPE_AGENT), t3 = __hip_atomic_load(sp + 3, __ATOMIC_RELAXED, __HIP_MEMORY_SCOPE_AGENT);
            float tot = ((__uint_as_float((unsigned)t0) + __uint_as_float((unsigned)(t0 >> 32))) + (__uint_as_float((unsigned)t1) + __uint_as_float((unsigned)(t1 >> 32))))
                      + ((__uint_as_float((unsigned)t2) + __uint_as_float((unsigned)(t2 >> 32))) + (__uint_as_float((unsigned)t3) + __uint_as_float((unsigned)(t3 >> 32))));
            tot += __shfl_xor(tot, 1);
            if (hf == 0) stab[rloc] = rsqrtf(tot * (1.f / 1024.f) + EPS);
        }
        asm volatile("s_waitcnt lgkmcnt(0)" ::: "memory"); __builtin_amdgcn_s_barrier(); asm volatile("" ::: "memory");
        const int col0 = u.pn * 256 + cw;
        const f32x4 g0 = *(const f32x4*)(gain + col0) * coef, g1 = *(const f32x4*)(gain + col0 + 4) * coef, g2 = *(const f32x4*)(gain + col0 + 128) * coef, g3 = *(const f32x4*)(gain + col0 + 132) * coef;
#pragma unroll
        for (int ai = 0; ai < 2; ++ai)
#pragma unroll
            for (int m = 0; m < 4; ++m) {
                const int r = rowb + ai * HALF + m * 16;
                const float rstd = stab[ai * HALF + wr * 64 + m * 16 + fr];
                bf16_t* xp = out + (size_t)r * 1024 + col0;
                const u32x4 xa = *(const u32x4*)xp, xb_ = *(const u32x4*)(xp + 128);
                const f32x4 a0 = acc[ai][0][m][0] * rstd, a1 = acc[ai][0][m][1] * rstd, b0 = acc[ai][1][m][0] * rstd, b1 = acc[ai][1][m][1] * rstd;
                f32x4 n0 = (f32x4){bflo(xa.x), bfhi(xa.x), bflo(xa.y), bfhi(xa.y)} + a0 * g0, n1 = (f32x4){bflo(xa.z), bfhi(xa.z), bflo(xa.w), bfhi(xa.w)} + a1 * g1;
                f32x4 n2 = (f32x4){bflo(xb_.x), bfhi(xb_.x), bflo(xb_.y), bfhi(xb_.y)} + b0 * g2, n3 = (f32x4){bflo(xb_.z), bfhi(xb_.z), bflo(xb_.w), bfhi(xb_.w)} + b1 * g3;
                u32x4 w; w.x = pk2(n0[0], n0[1]); w.y = pk2(n0[2], n0[3]); w.z = pk2(n1[0], n1[1]); w.w = pk2(n1[2], n1[3]); *(u32x4*)xp = w;
                w.x = pk2(n2[0], n2[1]); w.y = pk2(n2[2], n2[3]); w.z = pk2(n3[0], n3[1]); w.w = pk2(n3[2], n3[3]); *(u32x4*)(xp + 128) = w;
                const f32x4 q = n0 * n0 + n1 * n1 + n2 * n2 + n3 * n3; float sq = (q[0] + q[1]) + (q[2] + q[3]);
                sq += __shfl_xor(sq, 16); sq += __shfl_xor(sq, 32);
                if (fq == 0) ps2[(size_t)r * 16 + u.pn * 4 + wc] = sq;
            }
    }
#define EPI_ROWS(i) (rowb + ((i) >> 2) * HALF + ((i) & 3) * 16)
    template <bool F32OUT> __device__ __forceinline__ void gate_rows(const f32x4 (&acc)[2][2][4][2], const Unit& u, const float (&rsv)[8], int rowb, int cw, int wc, int fq) const {
#define EPI_ACC(i) const int ai = (i) >> 2, m = (i) & 3, r = EPI_ROWS(i); const float rs = rsv[i]; \
        const f32x4 a0 = acc[ai][0][m][0] * rs, a1 = acc[ai][0][m][1] * rs, b0 = acc[ai][1][m][0] * rs, b1 = acc[ai][1][m][1] * rs
#define EPI_PACK(w, p, q) w.x = pk2(p[0], p[1]); w.y = pk2(p[2], p[3]); w.z = pk2(q[0], q[1]); w.w = pk2(q[2], q[3])
#pragma unroll
            for (int hf = 0; hf < 8; ++hf) {
                u32x4 xr[1][2], pr[1][2];
#pragma unroll
                for (int m = 0; m < 1; ++m)
#pragma unroll
                    for (int bj = 0; bj < 2; ++bj) { const size_t off = (size_t)EPI_ROWS(hf + m) * 1024 + u.pn * 256 + bj * 128 + cw; xr[m][bj] = *(const u32x4*)(xin + off); pr[m][bj] = *(const u32x4*)(proj + off); }
#pragma unroll
                for (int m_ = 0; m_ < 1; ++m_) { EPI_ACC(hf + m_);
                    float sq = 0.f;
#pragma unroll
                    for (int bj = 0; bj < 2; ++bj) {
                        const size_t off = (size_t)r * 1024 + u.pn * 256 + bj * 128 + cw;
                        const f32x4 v0 = bj ? b0 : a0, v1 = bj ? b1 : a1; const u32x4 xv = xr[m_][bj], pv = pr[m_][bj];
                        f32x4 n0, n1;
                        n0[0] = bflo(xv.x) + sigm_f(v0[0]) * bflo(pv.x); n0[1] = bfhi(xv.x) + sigm_f(v0[1]) * bfhi(pv.x); n0[2] = bflo(xv.y) + sigm_f(v0[2]) * bflo(pv.y); n0[3] = bfhi(xv.y) + sigm_f(v0[3]) * bfhi(pv.y);
                        n1[0] = bflo(xv.z) + sigm_f(v1[0]) * bflo(pv.z); n1[1] = bfhi(xv.z) + sigm_f(v1[1]) * bfhi(pv.z); n1[2] = bflo(xv.w) + sigm_f(v1[2]) * bflo(pv.w); n1[3] = bfhi(xv.w) + sigm_f(v1[3]) * bfhi(pv.w);
                        if (F32OUT) { *(f32x4*)(xout + off) = n0; *(f32x4*)(xout + off + 4) = n1; }
                        u32x4 w; EPI_PACK(w, n0, n1); *(u32x4*)(xb + off) = w;
                        const f32x4 q = n0 * n0 + n1 * n1; sq += (q[0] + q[1]) + (q[2] + q[3]);
                    }
                    sq = fq_sum(sq);
                    if (fq == 0) ps[(size_t)r * 16 + u.pn * 4 + wc] = sq;
                }
            }
#undef EPI_ACC
#undef EPI_PACK
    }
    __device__ __forceinline__ void operator()(const f32x4 (&acc)[2][2][4][2], const Unit& u, int wr, int wc, int fr, int fq) const {
        if (mode == M_YRES) { yres(acc, u, wr, wc, fr, fq); return; }
        const int rowb = u.pm * BM + wr * 64 + fr, cw = wc * 32 + 8 * fq;
        float rsv[8];
        if (nparts == 16) {
#pragma unroll
            for (int hf = 0; hf < 2; ++hf) {
                f32x4 t[4];
#pragma unroll
                for (int i = 0; i < 4; ++i) t[i] = *(const f32x4*)(ssp + (size_t)EPI_ROWS(hf * 4 + i) * 16 + fq * 4);
#pragma unroll
                for (int i = 0; i < 4; ++i) { float v = (t[i][0] + t[i][1]) + (t[i][2] + t[i][3]); v = fq_sum(v); rsv[hf * 4 + i] = rsqrtf(v * (1.f / 1024.f) + EPS); }
            }
        } else if (nparts == 1) {
            float t[8];
#pragma unroll
            for (int i = 0; i < 8; ++i) t[i] = ssp[(size_t)EPI_ROWS(i) * 16];
#pragma unroll
            for (int i = 0; i < 8; ++i) rsv[i] = rsqrtf(t[i] * (1.f / 1024.f) + EPS);
        } else {
#pragma unroll
            for (int i = 0; i < 8; ++i) rsv[i] = 1.f;
        }
#define EPI_ACC(i) const int ai = (i) >> 2, m = (i) & 3, r = EPI_ROWS(i); const float rs = rsv[i]; \
        const f32x4 a0 = acc[ai][0][m][0] * rs, a1 = acc[ai][0][m][1] * rs, b0 = acc[ai][1][m][0] * rs, b1 = acc[ai][1][m][1] * rs
#define EPI_PACK(w, p, q) w.x = pk2(p[0], p[1]); w.y = pk2(p[2], p[3]); w.z = pk2(q[0], q[1]); w.w = pk2(q[2], q[3])
        if (mode == M_SWIGLU) {
#pragma unroll
            for (int i = 0; i < 8; ++i) { EPI_ACC(i);
                u32x4 w; w.x = pk2(silu_f(a0[0]) * b0[0], silu_f(a0[1]) * b0[1]); w.y = pk2(silu_f(a0[2]) * b0[2], silu_f(a0[3]) * b0[3]);
                w.z = pk2(silu_f(a1[0]) * b1[0], silu_f(a1[1]) * b1[1]); w.w = pk2(silu_f(a1[2]) * b1[2], silu_f(a1[3]) * b1[3]);
                *(u32x4*)(out + (size_t)r * ldc + u.pn * 128 + cw) = w; }
        } else if (mode == M_PLAIN) {
#pragma unroll
            for (int i = 0; i < 8; ++i) { EPI_ACC(i);
                u32x4 w; EPI_PACK(w, a0, a1); *(u32x4*)(out + (size_t)r * ldc + u.pn * 256 + cw) = w;
                EPI_PACK(w, b0, b1); *(u32x4*)(out + (size_t)r * ldc + u.pn * 256 + 128 + cw) = w; }
        } else if (mode == M_CONVIN) {
            if (u.pn < 4) {
#pragma unroll
                for (int i = 0; i < 8; ++i) { EPI_ACC(i);
                    u32x4 w; EPI_PACK(w, a0, a1); *(u32x4*)(out + (size_t)r * 1024 + u.pn * 256 + cw) = w;
                    EPI_PACK(w, b0, b1); *(u32x4*)(out + (size_t)r * 1024 + u.pn * 256 + 128 + cw) = w; }
            } else {
#pragma unroll
                for (int i = 0; i < 8; ++i) { EPI_ACC(i);
                    const f32x4 p0 = a0 * b0, p1 = a1 * b1; u32x4 w; EPI_PACK(w, p0, p1);
                    *(u32x4*)(out2 + (size_t)r * 1024 + (u.pn - 4) * 128 + cw) = w; }
            }
        } else if (mode == M_GATE) {
            if (xout) gate_rows<true>(acc, u, rsv, rowb, cw, wc, fq); else gate_rows<false>(acc, u, rsv, rowb, cw, wc, fq);
        } else if (mode == M_RETG) {
            const int hh = u.pn >> 1;
#pragma unroll
            for (int hf = 0; hf < 8; ++hf) {
                u32x4 oa[1], ob[1]; f32x4 st[1];
#pragma unroll
                for (int m = 0; m < 1; ++m) { const int rr = EPI_ROWS(hf + m); const bf16_t* op = out + (size_t)rr * ldc + u.pn * 256 + cw; oa[m] = *(const u32x4*)op; ob[m] = *(const u32x4*)(op + 128);
                    st[m] = *(const f32x4*)(stat + ((size_t)rr * 4 + hh) * 16 + fq * 4); }
#pragma unroll
                for (int m_ = 0; m_ < 1; ++m_) { EPI_ACC(hf + m_);
                    float s1 = st[m_][0] + st[m_][2], s2 = st[m_][1] + st[m_][3];
                    s1 = fq_sum(s1); s2 = fq_sum(s2);
                    const float mu = s1 * (1.f / 512.f), rstd = rsqrtf(fmaxf(s2 * (1.f / 512.f) - mu * mu, 0.f) + EPS);
                    bf16_t* op = out + (size_t)r * ldc + u.pn * 256 + cw; const u32x4 ov = oa[m_], ow = ob[m_];
                    u32x4 w;
                    w.x = pk2(silu_f(a0[0]) * (bflo(ov.x) - mu) * rstd, silu_f(a0[1]) * (bfhi(ov.x) - mu) * rstd); w.y = pk2(silu_f(a0[2]) * (bflo(ov.y) - mu) * rstd, silu_f(a0[3]) * (bfhi(ov.y) - mu) * rstd);
                    w.z = pk2(silu_f(a1[0]) * (bflo(ov.z) - mu) * rstd, silu_f(a1[1]) * (bfhi(ov.z) - mu) * rstd); w.w = pk2(silu_f(a1[2]) * (bflo(ov.w) - mu) * rstd, silu_f(a1[3]) * (bfhi(ov.w) - mu) * rstd);
                    *(u32x4*)op = w;
                    w.x = pk2(silu_f(b0[0]) * (bflo(ow.x) - mu) * rstd, silu_f(b0[1]) * (bfhi(ow.x) - mu) * rstd); w.y = pk2(silu_f(b0[2]) * (bflo(ow.y) - mu) * rstd, silu_f(b0[3]) * (bfhi(ow.y) - mu) * rstd);
                    w.z = pk2(silu_f(b1[0]) * (bflo(ow.z) - mu) * rstd, silu_f(b1[1]) * (bfhi(ow.z) - mu) * rstd); w.w = pk2(silu_f(b1[2]) * (bflo(ow.w) - mu) * rstd, silu_f(b1[3]) * (bfhi(ow.w) - mu) * rstd);
                    *(u32x4*)(op + 128) = w;
                }
            }
        } else {
            if (u.pn < 8) {
                const float sc = (u.pn >= 4) ? 0.0625f : 1.f;
#pragma unroll
                for (int hf = 0; hf < 8; ++hf) {
                    f32x4 cs[1][4];
#pragma unroll
                    for (int m = 0; m < 1; ++m) { const f32x4* cp = (const f32x4*)(rot + ((size_t)(EPI_ROWS(hf + m) & (SEQ - 1)) * 128 + cw) * 2); cs[m][0] = cp[0]; cs[m][1] = cp[1]; cs[m][2] = cp[2]; cs[m][3] = cp[3]; }
#pragma unroll
                    for (int m_ = 0; m_ < 1; ++m_) { EPI_ACC(hf + m_);
                        const f32x4 c0 = cs[m_][0], c1 = cs[m_][1], c2 = cs[m_][2], c3 = cs[m_][3];
                        f32x4 o0, o1, p0, p1;
                        o0[0] = (a0[0] * c0[0] - b0[0] * c0[1]) * sc; p0[0] = (a0[0] * c0[1] + b0[0] * c0[0]) * sc;
                        o0[1] = (a0[1] * c0[2] - b0[1] * c0[3]) * sc; p0[1] = (a0[1] * c0[3] + b0[1] * c0[2]) * sc;
                        o0[2] = (a0[2] * c1[0] - b0[2] * c1[1]) * sc; p0[2] = (a0[2] * c1[1] + b0[2] * c1[0]) * sc;
                        o0[3] = (a0[3] * c1[2] - b0[3] * c1[3]) * sc; p0[3] = (a0[3] * c1[3] + b0[3] * c1[2]) * sc;
                        o1[0] = (a1[0] * c2[0] - b1[0] * c2[1]) * sc; p1[0] = (a1[0] * c2[1] + b1[0] * c2[0]) * sc;
                        o1[1] = (a1[1] * c2[2] - b1[1] * c2[3]) * sc; p1[1] = (a1[1] * c2[3] + b1[1] * c2[2]) * sc;
                        o1[2] = (a1[2] * c3[0] - b1[2] * c3[1]) * sc; p1[2] = (a1[2] * c3[1] + b1[2] * c3[0]) * sc;
                        o1[3] = (a1[3] * c3[2] - b1[3] * c3[3]) * sc; p1[3] = (a1[3] * c3[3] + b1[3] * c3[2]) * sc;
                        u32x4 w; EPI_PACK(w, o0, o1); *(u32x4*)(out + (size_t)r * ldc + u.pn * 256 + cw) = w;
                        EPI_PACK(w, p0, p1); *(u32x4*)(out + (size_t)r * ldc + u.pn * 256 + 128 + cw) = w;
                    }
                }
            } else {
#pragma unroll
                for (int i = 0; i < 8; ++i) { EPI_ACC(i);
                    u32x4 w; EPI_PACK(w, a0, a1); *(u32x4*)(out + (size_t)r * ldc + u.pn * 256 + cw) = w;
                    EPI_PACK(w, b0, b1); *(u32x4*)(out + (size_t)r * ldc + u.pn * 256 + 128 + cw) = w; }
            }
        }
#undef EPI_ACC
#undef EPI_PACK
    }
};

__device__ __forceinline__ void gemm_phase(LAS unsigned char* lds, const Gemm g, const StaticOrder& S, const Epi& E, const int tid) {
    const int wid = __builtin_amdgcn_readfirstlane(tid >> 6), lane = tid & 63, wr = wid >> 2, wc = wid & 3, fr = lane & 15, fq = lane >> 4;
    const int K = g.K, nt = K / BK, lda = g.lda;
    unsigned voffA[2], voffB[2];
#pragma unroll
    for (int i = 0; i < 2; ++i) { int R, C; stage_rc(tid * 16 + i * 8192, R, C); const int Rb = (R & ~31) + perm32(R & 31);
        voffA[i] = (unsigned)(R * lda + C) * 2u; voffB[i] = (unsigned)(Rb * K + C) * 2u; }
    const size_t kstep = (size_t)(BK * 2);
    const size_t hstepA = (size_t)HALF * lda * 2, tstepA = 2 * hstepA;
    const size_t hstepB = (size_t)HALF * K * 2, tstepB = 2 * hstepB;
    const unsigned ldsw = (unsigned)wid * 1024u;
    const int aoff = lds_byte(wr * 64 + fr, fq * 8), boff = lds_byte(wc * 32 + fr, fq * 8);
#define PG8_SA(b, h) (((b) * 2 + (h)) * HTB)
#define PG8_SB(b, h) ((4 + (b) * 2 + (h)) * HTB)
#define PG8_STAGE(bufoff, gbase, voff) do { _Pragma("unroll") for (int _i = 0; _i < 2; ++_i) \
        __builtin_amdgcn_global_load_lds((const unsigned*)((const char*)(gbase) + (voff)[_i]), (LAS unsigned*)(lds + (bufoff) + ldsw + _i * 8192), 16, 0, 0); } while (0)
#define PG8_LDA(dst, b, h) do { _Pragma("unroll") for (int m = 0; m < 4; ++m) _Pragma("unroll") for (int k = 0; k < 2; ++k) dst[m][k] = *(const LAS bf16x8*)(lds + PG8_SA(b, h) + aoff + m * 2048 + k * 1024); } while (0)
#define PG8_LDB(dst, b, h) do { _Pragma("unroll") for (int n = 0; n < 2; ++n) _Pragma("unroll") for (int k = 0; k < 2; ++k) dst[n][k] = *(const LAS bf16x8*)(lds + PG8_SB(b, h) + boff + n * 2048 + k * 1024); } while (0)
#define PG8_MMA(ai, bj, At, Bt) do { __builtin_amdgcn_s_setprio(1); _Pragma("unroll") for (int m = 0; m < 4; ++m) _Pragma("unroll") for (int n = 0; n < 2; ++n) _Pragma("unroll") for (int k = 0; k < 2; ++k) \
        acc[ai][bj][m][n] = __builtin_amdgcn_mfma_f32_16x16x32_bf16(Bt[n][k], At[m][k], acc[ai][bj][m][n], 0, 0, 0); __builtin_amdgcn_s_setprio(0); } while (0)
#define PG8_WAIT_V(n) asm volatile("s_waitcnt vmcnt(" #n ")" ::: "memory")
#define PG8_WAIT_L(n) asm volatile("s_waitcnt lgkmcnt(" #n ")" ::: "memory")
#define PG8_BAR __builtin_amdgcn_s_barrier()
#define PG8_SCHED __builtin_amdgcn_sched_barrier(0)
    Unit cur, nxt; int ui = 0;
    if (!S.next(0, cur)) return;
    f32x4 acc[2][2][4][2];
#pragma unroll
    for (int a = 0; a < 2; ++a)
#pragma unroll
        for (int b = 0; b < 2; ++b)
#pragma unroll
            for (int m = 0; m < 4; ++m)
#pragma unroll
                for (int n = 0; n < 2; ++n) acc[a][b][m][n] = (f32x4){0.f, 0.f, 0.f, 0.f};
    bf16x8 At[4][2], B0[2][2], B1[2][2];
    const char* cA = (const char*)g.A + (size_t)cur.pm * tstepA; const char* cB = (const char*)g.Bt + (size_t)cur.pn * tstepB;
    PG8_STAGE(PG8_SB(0, 0), cB, voffB); PG8_STAGE(PG8_SB(0, 1), cB + hstepB, voffB); PG8_STAGE(PG8_SA(0, 0), cA, voffA); PG8_STAGE(PG8_SA(0, 1), cA + hstepA, voffA);
    if (wr == 1) PG8_BAR;
    PG8_WAIT_V(2); PG8_BAR;
    PG8_STAGE(PG8_SB(1, 0), cB + kstep, voffB); PG8_STAGE(PG8_SA(1, 0), cA + kstep, voffA); PG8_STAGE(PG8_SB(1, 1), cB + hstepB + kstep, voffB);
    PG8_WAIT_V(6); PG8_BAR;
    for (;;) {
        const bool has_next = S.next(ui + 1, nxt);
        const char* nA = has_next ? (const char*)g.A + (size_t)nxt.pm * tstepA : cA; const char* nB = has_next ? (const char*)g.Bt + (size_t)nxt.pn * tstepB : cB;
        for (int t = 0; t < nt; t += 2) {
            const bool last = (t == nt - 2);
            const char* a1 = cA + (size_t)(t + 1) * kstep;
            const char* a2 = last ? nA : cA + (size_t)(t + 2) * kstep; const char* b2 = last ? nB : cB + (size_t)(t + 2) * kstep;
            const char* a3 = a2 + kstep; const char* b3 = b2 + kstep;
            PG8_LDB(B0, 0, 0); PG8_LDB(B1, 0, 1); PG8_SCHED; PG8_LDA(At, 0, 0); PG8_STAGE(PG8_SA(1, 1), a1 + hstepA, voffA);
            PG8_WAIT_V(8); PG8_WAIT_L(0); PG8_BAR; PG8_MMA(0, 0, At, B0); PG8_MMA(0, 1, At, B1); PG8_BAR; PG8_SCHED;
            PG8_LDA(At, 0, 1); PG8_STAGE(PG8_SB(0, 0), b2, voffB); PG8_STAGE(PG8_SB(0, 1), b2 + hstepB, voffB); PG8_STAGE(PG8_SA(0, 0), a2, voffA);
            PG8_WAIT_V(8); PG8_WAIT_L(0); PG8_BAR; PG8_MMA(1, 0, At, B0); PG8_MMA(1, 1, At, B1); PG8_BAR; PG8_SCHED;
            PG8_LDB(B0, 1, 0); PG8_LDB(B1, 1, 1); PG8_SCHED; PG8_LDA(At, 1, 0); PG8_STAGE(PG8_SA(0, 1), a2 + hstepA, voffA);
            PG8_WAIT_V(8); PG8_WAIT_L(0); PG8_BAR; PG8_MMA(0, 0, At, B0); PG8_MMA(0, 1, At, B1); PG8_BAR; PG8_SCHED;
            PG8_LDA(At, 1, 1); PG8_STAGE(PG8_SB(1, 0), b3, voffB); PG8_STAGE(PG8_SB(1, 1), b3 + hstepB, voffB); PG8_STAGE(PG8_SA(1, 0), a3, voffA);
            PG8_WAIT_V(8); PG8_WAIT_L(0); PG8_BAR; PG8_MMA(1, 0, At, B0); PG8_MMA(1, 1, At, B1); PG8_BAR; PG8_SCHED;
        }
        if (wr == 0) PG8_BAR;
        E(acc, cur, wr, wc, fr, fq);
        if (!has_next) break;
#pragma unroll
        for (int a = 0; a < 2; ++a)
#pragma unroll
            for (int b = 0; b < 2; ++b)
#pragma unroll
                for (int m = 0; m < 4; ++m)
#pragma unroll
                    for (int n = 0; n < 2; ++n) acc[a][b][m][n] = (f32x4){0.f, 0.f, 0.f, 0.f};
        cur = nxt; cA = nA; cB = nB; ++ui;
        if (wr == 1) PG8_BAR;
    }
    PG8_WAIT_V(0);
    PG8_BAR;
}
}

__device__ __forceinline__ void cvt_item(const float* W, int K, int N, bf16_t* WT, int mode, const float* gain, LAS float* scr, int item, int lane) {
    const int nblk = N / 64, kb = item / nblk, nb = item % nblk, k0 = 64 * kb, n0 = 64 * nb;
    const int lr = lane >> 4, lc = (lane & 15) * 4;
    f32x4 v[16];
#pragma unroll
    for (int i = 0; i < 16; ++i) v[i] = *(const f32x4*)(W + (size_t)(k0 + 4 * i + lr) * N + n0 + lc);
#pragma unroll
    for (int i = 0; i < 16; ++i) { const int kk = 4 * i + lr; f32x4 t = v[i]; if (gain) t = t * gain[k0 + kk]; LAS float* d = scr + kk * 65 + lc; d[0] = t[0]; d[1] = t[1]; d[2] = t[2]; d[3] = t[3]; }
    LDS_WAIT();
    int d0 = n0;
    if (mode == 1) { const int half = N / 2, hi = n0 >= half, j = hi ? n0 - half : n0; d0 = (j / 128) * 256 + hi * 128 + (j % 128); }
    else if (mode == 2) { if (n0 >= 1024) { const int jj = (n0 - 1024) & 1023, isv = n0 >= 2048; d0 = 1024 + (jj / 128) * 256 + isv * 128 + (jj % 128); } }
    const int c = lane & 7;
#pragma unroll
    for (int j = 0; j < 8; ++j) { const int n = (lane >> 3) + 8 * j; const LAS float* p = scr + (8 * c) * 65 + n;
        u32x4 o; o.x = pk2(p[0 * 65], p[1 * 65]); o.y = pk2(p[2 * 65], p[3 * 65]); o.z = pk2(p[4 * 65], p[5 * 65]); o.w = pk2(p[6 * 65], p[7 * 65]);
        *(u32x4*)(WT + (size_t)(d0 + n) * K + k0 + 8 * c) = o; }
    LDS_WAIT();
}

#define XB_TMO      128
#define XB_XCNT(j)  (256  + 64 * (j))
#define XB_XSUB(j)  (1280 + 64 * (j))
#define XB_XGEN(j)  (2304 + 64 * (j))
#define XB_TOP      3328
#define XB_TOPGEN   3392
#define XCD_BAR_WORDS 3456
#define XB_SPIN_CAP (1u << 18)
__device__ __forceinline__ unsigned xb_ld(unsigned* p)              { return __hip_atomic_load(p, __ATOMIC_RELAXED, __HIP_MEMORY_SCOPE_AGENT); }
__device__ __forceinline__ unsigned xb_add(unsigned* p, unsigned v) { return __hip_atomic_fetch_add(p, v, __ATOMIC_RELAXED, __HIP_MEMORY_SCOPE_AGENT); }
__device__ __forceinline__ unsigned xb_xcc_id() { return (unsigned)__builtin_amdgcn_s_getreg((3 << 11) | 20) & 0xFu; }
#define XB_SPIN(cond, bar) do { unsigned _sp = 0; while (cond) { __builtin_amdgcn_s_sleep(1); \
    if ((++_sp & 255u) == 0u) { if (xb_ld(&(bar)[XB_TMO])) break; if (_sp > XB_SPIN_CAP) { atomicAdd(&(bar)[XB_TMO], 1u); break; } } } } while (0)
struct XcdBarrier { unsigned* bar; unsigned x; volatile LAS unsigned* st; };
__device__ __forceinline__ XcdBarrier xcd_barrier_post(unsigned* bar, volatile LAS unsigned* st) {
    XcdBarrier b; b.bar = bar; b.x = xb_xcc_id(); b.st = st;
    if (threadIdx.x == 0) (void)xb_add(&bar[XB_XCNT(b.x)], 1u);
    return b;
}
__device__ __forceinline__ void xcd_barrier_complete(unsigned* bar, unsigned x, unsigned& nloc, unsigned& nx) {
    const unsigned G = gridDim.x * gridDim.y * gridDim.z;
    unsigned sum, cnt, mine, sp = 0u;
    for (;;) {
        sum = 0u; cnt = 0u; mine = 0u;
#pragma unroll
        for (unsigned j = 0; j < 16; ++j) { const unsigned c = xb_ld(&bar[XB_XCNT(j)]); sum += c; cnt += (c > 0u) ? 1u : 0u; mine = (j == x) ? c : mine; }
        if (sum == G) break;
        __builtin_amdgcn_s_sleep(1);
        if ((++sp & 255u) == 0u) { if (xb_ld(&bar[XB_TMO])) break; if (sp > XB_SPIN_CAP) { atomicAdd(&bar[XB_TMO], 1u); break; } }
    }
    nloc = mine > 0u ? mine : 1u; nx = cnt > 0u ? cnt : 1u;
}
__device__ __forceinline__ void xcd_barrier(const XcdBarrier& b) {
    asm volatile("s_waitcnt vmcnt(0)" ::: "memory");
    __syncthreads();
    if (__builtin_amdgcn_mbcnt_hi(~0u, __builtin_amdgcn_mbcnt_lo(~0u, 0u)) == 0u && __builtin_amdgcn_readfirstlane(threadIdx.x) == 0) {
        unsigned* bar = b.bar;
        __builtin_amdgcn_s_waitcnt(0);
        unsigned nloc = b.st[0], nx = b.st[1];
        if (nloc == 0u) { xcd_barrier_complete(bar, b.x, nloc, nx); b.st[0] = nloc; b.st[1] = nx; }
        const unsigned old = xb_add(&bar[XB_XSUB(b.x)], 1u);
        const unsigned gen = old / nloc;
        if (old + 1u == (gen + 1u) * nloc) {
            __builtin_amdgcn_fence(__ATOMIC_RELEASE, "agent");
            asm volatile("s_waitcnt vmcnt(0)" ::: "memory");
            const unsigned og = xb_add(&bar[XB_TOP], 1u);
            const unsigned tg = og / nx;
            if (og + 1u == (tg + 1u) * nx) xb_add(&bar[XB_TOPGEN], 1u);
            else XB_SPIN(xb_ld(&bar[XB_TOPGEN]) == tg, bar);
            __builtin_amdgcn_fence(__ATOMIC_ACQUIRE, "agent");
            xb_add(&bar[XB_XGEN(b.x)], 1u);
            asm volatile("s_waitcnt vmcnt(0)" ::: "memory");
        } else {
            XB_SPIN(xb_ld(&bar[XB_XGEN(b.x)]) == gen, bar);
            __builtin_amdgcn_fence(__ATOMIC_ACQUIRE, "agent");
            asm volatile("s_waitcnt vmcnt(0)" ::: "memory");
        }
    }
    __syncthreads();
}

struct Params { const float* in[16]; float* out; unsigned char* ws; int ph_lo, ph_hi; };

__global__ void __launch_bounds__(512) fwd_kernel(Params P) {
    extern __shared__ __attribute__((aligned(16))) unsigned char smem[];
    LAS unsigned char* lds = (LAS unsigned char*)smem;
    cg::grid_group grid = cg::this_grid();
    const int wave = __builtin_amdgcn_readfirstlane(threadIdx.x >> 6);
    const int G = gridDim.x, gw = blockIdx.x * 8 + wave, NGW = G * 8;
    unsigned char* ws = P.ws;
    bf16_t* Wb = (bf16_t*)(ws + WS_W);
    bf16_t* XB = (bf16_t*)(ws + WS_XB);
    bf16_t* YB = (bf16_t*)(ws + WS_Y);
    bf16_t* ACT = (bf16_t*)(ws + WS_ACT);
    bf16_t* PB = (bf16_t*)(ws + WS_PB);
    unsigned* CNT = (unsigned*)(ws + WS_CNT);
    float* SSP = (float*)(ws + WS_SSP);
    float* PS = (float*)(ws + WS_PS);
    float* ROT = (float*)(ws + WS_ROT);
    float* STAT = (float*)(ws + WS_STAT);
    const float* x_in = P.in[0]; const float* p_in = P.in[1]; const float* norm_g = P.in[2];
    float* X = P.out;
    const bool multi = (P.ph_hi - P.ph_lo) > 1;
    volatile LAS unsigned* bst = (volatile LAS unsigned*)(lds + LDS_BST);
    if (threadIdx.x < 4) bst[threadIdx.x] = 0u;
    __syncthreads();
    XcdBarrier xbar = xcd_barrier_post((unsigned*)(ws + WS_BAR), bst);

    for (int step = P.ph_lo; step < P.ph_hi; ++step) {
        int tid = wave * 64 + (int)__builtin_amdgcn_mbcnt_hi(~0u, __builtin_amdgcn_mbcnt_lo(~0u, 0u)); asm volatile("" : "+v"(tid));
        const int lane = tid & 63, fr = lane & 15, fq = lane >> 4;
        const int L = step / NSTEP_L, s = step % NSTEP_L, kind = L % 3, jl = L / 3;
        const float* ng = norm_g + (size_t)L * 7 * 1024;
        bf16_t* Xc = (L & 1) ? YB : XB;
        bf16_t* Yo = (L & 1) ? XB : YB;
        bool is_gemm = false, do_sync = true;
        pg8::Gemm gm{}; pg8::Epi E{};
        if (s == 0) {
            LAS float* scr = (LAS float*)(lds + wave * 16640);
            const float* wgu = P.in[3] + (size_t)L * 2 * 1024 * 5632; const float* wdn = P.in[4] + (size_t)L * 2 * 2816 * 1024;
            const float* wpj = P.in[5] + (size_t)L * 256 * 1024; const float* wgt = P.in[6] + (size_t)L * 1024 * 1024;
            const float* wmi; const float* wmo; int nmi, kmo, mmode;
            if (kind == 0) { wmi = P.in[8] + (size_t)jl * 1024 * 3072; wmo = P.in[10] + (size_t)jl * 1024 * 1024; nmi = 3072; kmo = 1024; mmode = 2; }
            else if (kind == 1) { wmi = P.in[11] + (size_t)jl * 1024 * 1280; wmo = P.in[13] + (size_t)jl * 1024 * 1024; nmi = 1280; kmo = 1024; mmode = 0; }
            else { wmi = P.in[14] + (size_t)jl * 1024 * 6144; wmo = P.in[15] + (size_t)jl * 2048 * 1024; nmi = 6144; kmo = 2048; mmode = 0; }
            const int I_GU = 16 * 88, I_DN = 44 * 16, I_GT = 16 * 16, I_PJ = 4 * 16, I_MI = 16 * (nmi / 64), I_MO = (kmo / 64) * 16;
            const int NIT = 2 * I_GU + 2 * I_DN + I_GT + I_PJ + I_MI + I_MO;
            for (int it = gw; it < NIT; it += NGW) {
                int r = it;
                if (r < I_GU) { cvt_item(wgu, 1024, 5632, Wb + W_GU0, 1, ng + 0 * 1024, scr, r, lane); continue; } r -= I_GU;
                if (r < I_GU) { cvt_item(wgu + (size_t)1024 * 5632, 1024, 5632, Wb + W_GU1, 1, ng + 4 * 1024, scr, r, lane); continue; } r -= I_GU;
                if (r < I_DN) { cvt_item(wdn, 2816, 1024, Wb + W_DN0, 0, nullptr, scr, r, lane); continue; } r -= I_DN;
                if (r < I_DN) { cvt_item(wdn + (size_t)2816 * 1024, 2816, 1024, Wb + W_DN1, 0, nullptr, scr, r, lane); continue; } r -= I_DN;
                if (r < I_GT) { cvt_item(wgt, 1024, 1024, Wb + W_GATE, 0, ng + 6 * 1024, scr, r, lane); continue; } r -= I_GT;
                if (r < I_PJ) { cvt_item(wpj, 256, 1024, Wb + W_PROJ, 0, nullptr, scr, r, lane); continue; } r -= I_PJ;
                if (r < I_MI) { cvt_item(wmi, 1024, nmi, Wb + W_MIN, mmode, ng + 2 * 1024, scr, r, lane); continue; } r -= I_MI;
                cvt_item(wmo, kmo, 1024, Wb + W_MOUT, 0, nullptr, scr, r, lane);
            }
            {
                const float* pin = p_in + (size_t)L * T * 256;
                for (int m = gw; m < T; m += NGW) { const f32x4 pv = *((const f32x4*)(pin + (size_t)m * 256) + lane); u32x2 w; w.x = pk2(pv[0], pv[1]); w.y = pk2(pv[2], pv[3]); *((u32x2*)(PB + (size_t)m * 256) + lane) = w; }
            }
            if (L == 0) {
                for (int m = gw; m < T; m += NGW) {
                    const f32x4* xr = (const f32x4*)(x_in + (size_t)m * 1024) + lane; float ss = 0.f;
#pragma unroll
                    for (int j = 0; j < 4; ++j) { const f32x4 v = xr[64 * j]; ss += (v[0] * v[0] + v[1] * v[1]) + (v[2] * v[2] + v[3] * v[3]);
                        u32x2 w; w.x = pk2(v[0], v[1]); w.y = pk2(v[2], v[3]); *((u32x2*)(XB + (size_t)m * 1024) + lane + 64 * j) = w; }
                    ss = wave_sum(ss); if (lane == 0) SSP[(size_t)m * 16] = ss;
                }
                for (int e = blockIdx.x * 512 + tid; e < SEQ * 128; e += G * 512) {
                    const int pos = e >> 7, d = e & 127;
                    const float inv = exp2f(-(float)d * (1.f / 128.f) * 13.287712379549449f);
                    const float ang = (float)pos * inv;
                    const double rev = (double)ang * 0.15915494309189535; const float fr_ = (float)(rev - rint(rev));
                    ROT[2 * (size_t)e] = __builtin_amdgcn_cosf(fr_); ROT[2 * (size_t)e + 1] = __builtin_amdgcn_sinf(fr_);
                }
            }
        } else if (s == 1 || s == 9) {
            const int f = (s == 9);
            const bool from_gate = (s == 1 && L > 0);
            gm = pg8::Gemm{Xc, Wb + (f ? W_GU1 : W_GU0), T, 5632, 1024, 1024};
            E.mode = pg8::M_SWIGLU; E.out = ACT; E.ldc = FF; E.ssp = from_gate ? PS : SSP; E.nparts = (s == 1 && L == 0) ? 1 : 16; is_gemm = true;
        } else if (s == 2 || s == 10) {
            const int f = (s == 10);
            gm = pg8::Gemm{ACT, Wb + (f ? W_DN1 : W_DN0), T, 1024, FF, FF};
            E.mode = pg8::M_YRES; E.stab = (LAS float*)(lds + 131072); E.out = Xc; E.ps = PS; E.ps2 = SSP; E.gain = ng + (f ? 5 : 1) * 1024; E.coef = 0.5f; E.cnt = CNT + (size_t)(L * 3 + (f ? 2 : 0)) * 128 * 16; is_gemm = true;
        } else if (s == 3 || s == 8 || s == 11) {
            continue;
        } else if (s == 99) {
            const float* gain = ng + (s == 3 ? 1 : (s == 8 ? 3 : 5)) * 1024; const float coef = (s == 8) ? 1.f : 0.5f;
            const bf16_t* Ysrc = Yo;
            const float* pin = (s == 11) ? p_in + (size_t)L * T * 256 : nullptr;
            f32x4 gv[4];
#pragma unroll
            for (int j = 0; j < 4; ++j) gv[j] = *((const f32x4*)gain + lane + 64 * j) * coef;
            for (int m = gw; m < T; m += NGW) {
                float sp = (lane < 16) ? PS[(size_t)m * 16 + lane] : 0.f; sp = wave_sum(sp);
                const float rstd = rsqrtf(sp * (1.f / 1024.f) + EPS);
                float ss = 0.f;
#pragma unroll
                for (int j = 0; j < 4; ++j) {
                    const u32x2 xr = *((const u32x2*)(Xc + (size_t)m * 1024) + lane + 64 * j);
                    f32x4 xv = (f32x4){bflo(xr.x), bfhi(xr.x), bflo(xr.y), bfhi(xr.y)};
                    const u32x2 yv = *((const u32x2*)(Ysrc + (size_t)m * 1024) + lane + 64 * j);
                    xv[0] += bflo(yv.x) * rstd * gv[j][0]; xv[1] += bfhi(yv.x) * rstd * gv[j][1]; xv[2] += bflo(yv.y) * rstd * gv[j][2]; xv[3] += bfhi(yv.y) * rstd * gv[j][3];
                    ss += (xv[0] * xv[0] + xv[1] * xv[1]) + (xv[2] * xv[2] + xv[3] * xv[3]);
                    u32x2 w; w.x = pk2(xv[0], xv[1]); w.y = pk2(xv[2], xv[3]); *((u32x2*)(Xc + (size_t)m * 1024) + lane + 64 * j) = w;
                }
                ss = wave_sum(ss); if (lane == 0) SSP[(size_t)m * 16] = ss;
                if (pin) { const f32x4 pv = *((const f32x4*)(pin + (size_t)m * 256) + lane); u32x2 w; w.x = pk2(pv[0], pv[1]); w.y = pk2(pv[2], pv[3]); *((u32x2*)(PB + (size_t)m * 256) + lane) = w; }
            }
        } else if (s == 4) {
            const int nmi = kind == 0 ? 3072 : (kind == 1 ? 1280 : 4096);
            gm = pg8::Gemm{Xc, Wb + W_MIN, T, nmi, 1024, 1024};
            E.ssp = SSP; E.nparts = 16; is_gemm = true;
            if (kind == 0) { E.mode = pg8::M_CONVIN; E.out = ACT; E.out2 = ACT + (size_t)T * 1024; E.ldc = 1024; }
            else if (kind == 1) { E.mode = pg8::M_PLAIN; E.out = ACT; E.ldc = 1280; }
            else { E.mode = pg8::M_RET; E.out = ACT; E.ldc = 6144; E.rot = ROT; }
        } else if (s == 5) {
            if (kind == 0) {
                const bf16_t* BG = ACT; const bf16_t* CV = ACT + (size_t)T * 1024; bf16_t* Mo = ACT + (size_t)2 * T * 1024;
                const float* cw_ = P.in[9] + (size_t)jl * 3 * 1024;
                f32x4 w0[4], w1[4], w2[4];
#pragma unroll
                for (int j = 0; j < 4; ++j) { w0[j] = *((const f32x4*)cw_ + lane + 64 * j); w1[j] = *((const f32x4*)(cw_ + 1024) + lane + 64 * j); w2[j] = *((const f32x4*)(cw_ + 2048) + lane + 64 * j); }
                const int rows_per = T / NGW;
                for (int m0 = gw * rows_per; m0 < T; m0 += NGW * rows_per) {
                    f32x4 p2[4], p1[4];
                    const bool has_prev = (m0 & (SEQ - 1)) != 0;
#pragma unroll
                    for (int j = 0; j < 4; ++j) {
                        if (has_prev) { const u32x2 a = *((const u32x2*)(CV + (size_t)(m0 - 2) * 1024) + lane + 64 * j), b = *((const u32x2*)(CV + (size_t)(m0 - 1) * 1024) + lane + 64 * j);
                            p2[j] = (f32x4){bflo(a.x), bfhi(a.x), bflo(a.y), bfhi(a.y)}; p1[j] = (f32x4){bflo(b.x), bfhi(b.x), bflo(b.y), bfhi(b.y)}; }
                        else { p2[j] = (f32x4){0.f, 0.f, 0.f, 0.f}; p1[j] = p2[j]; }
                    }
                    for (int i0 = 0; i0 < rows_per; i0 += 4) {
                        u32x2 cq[4][4], bq[4][4];
#pragma unroll
                        for (int q = 0; q < 4; ++q)
#pragma unroll
                            for (int j = 0; j < 4; ++j) { const size_t m = (size_t)(m0 + i0 + q); cq[q][j] = *((const u32x2*)(CV + m * 1024) + lane + 64 * j); bq[q][j] = *((const u32x2*)(BG + m * 1024) + lane + 64 * j); }
#pragma unroll
                        for (int q = 0; q < 4; ++q) {
                            const size_t m = (size_t)(m0 + i0 + q);
#pragma unroll
                            for (int j = 0; j < 4; ++j) {
                                const u32x2 c = cq[q][j], bg = bq[q][j];
                                const f32x4 cv = (f32x4){bflo(c.x), bfhi(c.x), bflo(c.y), bfhi(c.y)}, bv = (f32x4){bflo(bg.x), bfhi(bg.x), bflo(bg.y), bfhi(bg.y)};
                                const f32x4 o = bv * (w0[j] * p2[j] + w1[j] * p1[j] + w2[j] * cv);
                                u32x2 w; w.x = pk2(o[0], o[1]); w.y = pk2(o[2], o[3]); *((u32x2*)(Mo + m * 1024) + lane + 64 * j) = w;
                                p2[j] = p1[j]; p1[j] = cv;
                            }
                        }
                    }
                }
            } else if (kind == 1) {
                LAS bf16_t* Ks = (LAS bf16_t*)lds;
                LAS bf16_t* VTs = (LAS bf16_t*)(lds + 36864);
                LAS float* BI = (LAS float*)(lds + 36864 + 33792);
                LAS float* SK = BI + 1024;
                const bf16_t* QKV = ACT; bf16_t* Oo = ACT + (size_t)2 * T * 1024;
                const float* relb = P.in[7]; const float* sinks = P.in[12] + (size_t)jl * 16;
#ifdef SWA_TRIVIAL
                for (int m = gw; m < T; m += NGW) { *((u32x4*)(Oo + (size_t)m * 1024) + lane) = *((const u32x4*)(QKV + (size_t)m * 1280) + lane); *((u32x4*)(Oo + (size_t)m * 1024) + 64 + lane) = *((const u32x4*)(QKV + (size_t)m * 1280) + 64 + lane); }
                for (int item = blockIdx.x; item < 0; item += G) {
#else
                for (int item = blockIdx.x; item < 512; item += G) {
#endif
                    const int kvh = item & 1, nb = (item >> 1) & 31, b = item >> 6;
                    __syncthreads();
                    for (int e = tid; e < 1024; e += 512) { const int gg = e >> 7, dist = e & 127; int bucket = dist;
                        if (dist >= 16) { const float d = (float)dist; int lg_ = 16 + (int)(logf(d / 16.f) / 2.0794415416798357f * 16.f); bucket = lg_ < 31 ? lg_ : 31; }
                        BI[e] = relb[bucket * 16 + kvh * 8 + gg]; }
                    if (tid < 8) SK[tid] = sinks[kvh * 8 + tid];
#pragma unroll
                    for (int i = 0; i < 4; ++i) {
                        const int q = tid + 512 * i, kk = q >> 3, c8 = q & 7; const bool valid = (nb > 0) || (kk >= 128);
                        u32x4 kv = (u32x4){0u, 0u, 0u, 0u}, vv = kv;
                        if (valid) { const size_t rk = (size_t)b * SEQ + (size_t)(nb - 1) * 128 + kk; kv = *(const u32x4*)(QKV + rk * 1280 + 1024 + kvh * 64 + c8 * 8); vv = *(const u32x4*)(QKV + rk * 1280 + 1152 + kvh * 64 + c8 * 8); }
                        *(LAS u32x4*)(Ks + kk * 72 + c8 * 8) = kv;
                        LAS bf16_t* vt = VTs + (c8 * 8) * 264 + kk;
                        vt[0 * 264] = (bf16_t)(vv.x & 0xffff); vt[1 * 264] = (bf16_t)(vv.x >> 16); vt[2 * 264] = (bf16_t)(vv.y & 0xffff); vt[3 * 264] = (bf16_t)(vv.y >> 16);
                        vt[4 * 264] = (bf16_t)(vv.z & 0xffff); vt[5 * 264] = (bf16_t)(vv.z >> 16); vt[6 * 264] = (bf16_t)(vv.w & 0xffff); vt[7 * 264] = (bf16_t)(vv.w >> 16);
                    }
                    __syncthreads();
                    const int gg = wave, h = kvh * 8 + gg; const float sink = SK[gg];
                    for (int it = 0; it < 8; ++it) {
                        const int i0 = 16 * it; const size_t r = (size_t)b * SEQ + (size_t)nb * 128 + i0 + fr;
                        bf16x8 qf[2];
#pragma unroll
                        for (int ks = 0; ks < 2; ++ks) qf[ks] = *(const bf16x8*)(QKV + r * 1280 + h * 64 + 32 * ks + fq * 8);
                        float lg[9][4]; float mx = sink;
#pragma unroll
                        for (int t = 0; t < 9; ++t) {
                            const int kt = it + t; f32x4 a = (f32x4){0.f, 0.f, 0.f, 0.f};
#pragma unroll
                            for (int ks = 0; ks < 2; ++ks) { const bf16x8 kf = *(const LAS bf16x8*)(Ks + (16 * kt + fr) * 72 + 32 * ks + fq * 8); a = __builtin_amdgcn_mfma_f32_16x16x32_bf16(kf, qf[ks], a, 0, 0, 0); }
#pragma unroll
                            for (int jj = 0; jj < 4; ++jj) { const int kk = 16 * kt + fq * 4 + jj, dist = i0 + fr + 128 - kk; const bool valid = (dist >= 0) && (dist < 128) && ((nb > 0) || (kk >= 128));
                                const float v = valid ? a[jj] * 0.125f + BI[gg * 128 + (dist & 127)] : -INFINITY; lg[t][jj] = v; mx = fmaxf(mx, v); }
                        }
                        mx = fq_max(mx);
                        float sum = 0.f;
#pragma unroll
                        for (int t = 0; t < 9; ++t)
#pragma unroll
                            for (int jj = 0; jj < 4; ++jj) { const float e = __expf(lg[t][jj] - mx); lg[t][jj] = e; sum += e; }
                        sum = fq_sum(sum);
                        const float inv = 1.f / (sum + __expf(sink - mx));
                        bf16x4 pf[9];
#pragma unroll
                        for (int t = 0; t < 9; ++t) { const unsigned lo = pk2(lg[t][0] * inv, lg[t][1] * inv), hi = pk2(lg[t][2] * inv, lg[t][3] * inv);
                            pf[t] = (bf16x4){(short)(lo & 0xffff), (short)(lo >> 16), (short)(hi & 0xffff), (short)(hi >> 16)}; }
#pragma unroll
                        for (int dt = 0; dt < 4; ++dt) {
                            f32x4 o = (f32x4){0.f, 0.f, 0.f, 0.f};
#pragma unroll
                            for (int t = 0; t < 9; ++t) { const bf16x4 vf = *(const LAS bf16x4*)(VTs + (16 * dt + fr) * 264 + 16 * (it + t) + fq * 4); o = __builtin_amdgcn_mfma_f32_16x16x16bf16_1k(vf, pf[t], o, 0, 0, 0); }
                            u32x2 w; w.x = pk2(o[0], o[1]); w.y = pk2(o[2], o[3]); *(u32x2*)(Oo + r * 1024 + h * 64 + 16 * dt + fq * 4) = w;
                        }
                    }
                }
            } else {
                LAS bf16_t* Kn = (LAS bf16_t*)lds;
                LAS bf16_t* VTs = (LAS bf16_t*)(lds + 67584);
                LAS bf16_t* VdT = (LAS bf16_t*)(lds + 67584 + 17408);
                LAS bf16_t* STs = (LAS bf16_t*)(lds + 67584 + 2 * 17408);
                bf16_t* Q = ACT;
                for (int item = blockIdx.x; item < 256; item += G) {
                    const int ix = item >> 3, ph = (item & 7) * 4 + (ix >> 3), vs = ix & 7, h = ph & 3, b = ph >> 2;
                    const float lgam = logf(1.f - exp2f(-5.f - (float)h));
                    const float cd = __expf(lgam * 128.f);
                    __syncthreads();
                    for (int e = tid; e < 64 * 264 / 2; e += 512) ((LAS unsigned*)STs)[e] = 0u;
                    f32x4 sacc[4][2];
#pragma unroll
                    for (int dt = 0; dt < 4; ++dt)
#pragma unroll
                        for (int nt = 0; nt < 2; ++nt) sacc[dt][nt] = (f32x4){0.f, 0.f, 0.f, 0.f};
                    const float d0 = __expf(lgam * (float)(127 - 2 * lane)), d1 = __expf(lgam * (float)(126 - 2 * lane));
                    const int iq = 16 * wave + fr; const float qd = __expf(lgam * (float)(iq + 1));
                    const float rf0 = __expf(lgam * (float)(iq - fq * 4)), g16 = __expf(-16.f * lgam);
                    float cfj[4];
#pragma unroll
                    for (int jj = 0; jj < 4; ++jj) cfj[jj] = __expf(-lgam * (float)jj);
                    const size_t kcol = 1024 + h * 256, vcol = 2048 + h * 512 + vs * 64;
                    u32x4 kreg[8], vreg[2]; bf16x8 qf[8];
                    {
                        const size_t rb = (size_t)b * SEQ;
#pragma unroll
                        for (int i = 0; i < 8; ++i) { const int p = tid + 512 * i; kreg[i] = *(const u32x4*)(Q + (rb + (p >> 5)) * 6144 + kcol + (p & 31) * 8); }
#pragma unroll
                        for (int rr = 0; rr < 2; ++rr) vreg[rr] = *(const u32x4*)(Q + (rb + 2 * lane + rr) * 6144 + vcol + wave * 8);
#pragma unroll
                        for (int ks = 0; ks < 8; ++ks) qf[ks] = *(const bf16x8*)(Q + (rb + iq) * 6144 + h * 256 + 32 * ks + fq * 8);
                    }
                    for (int c = 0; c < 32; ++c) {
                        const size_t rb = (size_t)b * SEQ + (size_t)c * 128;
#pragma unroll
                        for (int i = 0; i < 8; ++i) { const int p = tid + 512 * i; *(LAS u32x4*)(Kn + (p >> 5) * 264 + (p & 31) * 8) = kreg[i]; }
                        {
                            const u32x4 v0 = vreg[0], v1 = vreg[1]; LAS unsigned* dst = (LAS unsigned*)(VTs + (wave * 8) * 136 + 2 * lane); LAS unsigned* dsd = (LAS unsigned*)(VdT + (wave * 8) * 136 + 2 * lane);
                            dst[0 * 68] = (v0.x & 0xffffu) | (v1.x << 16); dst[1 * 68] = (v0.x >> 16) | (v1.x & 0xffff0000u);
                            dst[2 * 68] = (v0.y & 0xffffu) | (v1.y << 16); dst[3 * 68] = (v0.y >> 16) | (v1.y & 0xffff0000u);
                            dst[4 * 68] = (v0.z & 0xffffu) | (v1.z << 16); dst[5 * 68] = (v0.z >> 16) | (v1.z & 0xffff0000u);
                            dst[6 * 68] = (v0.w & 0xffffu) | (v1.w << 16); dst[7 * 68] = (v0.w >> 16) | (v1.w & 0xffff0000u);
                            dsd[0 * 68] = pk2(bflo(v0.x) * d0, bflo(v1.x) * d1); dsd[1 * 68] = pk2(bfhi(v0.x) * d0, bfhi(v1.x) * d1);
                            dsd[2 * 68] = pk2(bflo(v0.y) * d0, bflo(v1.y) * d1); dsd[3 * 68] = pk2(bfhi(v0.y) * d0, bfhi(v1.y) * d1);
                            dsd[4 * 68] = pk2(bflo(v0.z) * d0, bflo(v1.z) * d1); dsd[5 * 68] = pk2(bfhi(v0.z) * d0, bfhi(v1.z) * d1);
                            dsd[6 * 68] = pk2(bflo(v0.w) * d0, bflo(v1.w) * d1); dsd[7 * 68] = pk2(bfhi(v0.w) * d0, bfhi(v1.w) * d1);
                        }
                        __syncthreads();
                        {
                            const size_t rn = rb + (c < 31 ? 128 : 0);
#pragma unroll
                            for (int i = 0; i < 8; ++i) { const int p = tid + 512 * i; kreg[i] = *(const u32x4*)(Q + (rn + (p >> 5)) * 6144 + kcol + (p & 31) * 8); }
#pragma unroll
                            for (int rr = 0; rr < 2; ++rr) vreg[rr] = *(const u32x4*)(Q + (rn + 2 * lane + rr) * 6144 + vcol + wave * 8);
                        }
#pragma unroll
                        for (int dt = 0; dt < 4; ++dt)
#pragma unroll
                            for (int nt = 0; nt < 2; ++nt) sacc[dt][nt] = sacc[dt][nt] * cd;
#pragma unroll
                        for (int ks = 0; ks < 8; ++ks) {
                            bf16x4 vf[4];
#pragma unroll
                            for (int dt = 0; dt < 4; ++dt) vf[dt] = *(const LAS bf16x4*)(VdT + (16 * dt + fr) * 136 + 16 * ks + fq * 4);
#pragma unroll
                            for (int nt = 0; nt < 2; ++nt) {
                                const LAS bf16_t* kp = Kn + (16 * ks + fq * 4) * 264 + 32 * wave + 16 * nt + fr;
                                const bf16x4 kf = (bf16x4){(short)kp[0], (short)kp[264], (short)kp[2 * 264], (short)kp[3 * 264]};
#pragma unroll
                                for (int dt = 0; dt < 4; ++dt) sacc[dt][nt] = __builtin_amdgcn_mfma_f32_16x16x16bf16_1k(vf[dt], kf, sacc[dt][nt], 0, 0, 0);
                            }
                        }
                        f32x4 oacc[4];
#pragma unroll
                        for (int dt = 0; dt < 4; ++dt) oacc[dt] = (f32x4){0.f, 0.f, 0.f, 0.f};
                        float rf = rf0;
                        for (int jt = 0; jt <= wave; ++jt) {
                            f32x4 a = (f32x4){0.f, 0.f, 0.f, 0.f}, a2 = a;
#pragma unroll
                            for (int kh = 0; kh < 8; kh += 4) {
                                bf16x8 kf[4];
#pragma unroll
                                for (int ks = 0; ks < 4; ++ks) kf[ks] = *(const LAS bf16x8*)(Kn + (16 * jt + fr) * 264 + 32 * (kh + ks) + fq * 8);
                                asm volatile("" : "+v"(kf[0]), "+v"(kf[1]), "+v"(kf[2]), "+v"(kf[3]));
#pragma unroll
                                for (int ks = 0; ks < 4; ks += 2) { a = __builtin_amdgcn_mfma_f32_16x16x32_bf16(kf[ks], qf[kh + ks], a, 0, 0, 0); a2 = __builtin_amdgcn_mfma_f32_16x16x32_bf16(kf[ks + 1], qf[kh + ks + 1], a2, 0, 0, 0); }
                            }
                            a = a + a2;
                            float pv[4];
#pragma unroll
                            for (int jj = 0; jj < 4; ++jj) { const int dj = iq - (16 * jt + fq * 4 + jj); pv[jj] = (dj >= 0) ? a[jj] * (rf * cfj[jj]) : 0.f; }
                            rf *= g16;
                            const unsigned lo = pk2(pv[0], pv[1]), hi = pk2(pv[2], pv[3]);
                            const bf16x4 pf = (bf16x4){(short)(lo & 0xffff), (short)(lo >> 16), (short)(hi & 0xffff), (short)(hi >> 16)};
#pragma unroll
                            for (int dt = 0; dt < 4; ++dt) { const bf16x4 vf = *(const LAS bf16x4*)(VTs + (16 * dt + fr) * 136 + 16 * jt + fq * 4); oacc[dt] = __builtin_amdgcn_mfma_f32_16x16x16bf16_1k(vf, pf, oacc[dt], 0, 0, 0); }
                        }
                        f32x4 cross[4];
#pragma unroll
                        for (int dt = 0; dt < 4; ++dt) { cross[dt] = (f32x4){0.f, 0.f, 0.f, 0.f};
#pragma unroll
                            for (int ks = 0; ks < 8; ++ks) { const bf16x8 sf = *(const LAS bf16x8*)(STs + (16 * dt + fr) * 264 + 32 * ks + fq * 8); cross[dt] = __builtin_amdgcn_mfma_f32_16x16x32_bf16(sf, qf[ks], cross[dt], 0, 0, 0); } }
                        {
                            const size_t rq = rb + (c < 31 ? 128 : 0) + iq;
#pragma unroll
                            for (int ks = 0; ks < 8; ++ks) qf[ks] = *(const bf16x8*)(Q + rq * 6144 + h * 256 + 32 * ks + fq * 8);
                        }
                        float s1 = 0.f, s2 = 0.f;
#pragma unroll
                        for (int dt = 0; dt < 4; ++dt) { const f32x4 o = oacc[dt] + cross[dt] * qd; s1 += (o[0] + o[1]) + (o[2] + o[3]); s2 += (o[0] * o[0] + o[1] * o[1]) + (o[2] * o[2] + o[3] * o[3]);
                            u32x2 w; w.x = pk2(o[0], o[1]); w.y = pk2(o[2], o[3]); *(u32x2*)(Q + (rb + iq) * 6144 + vcol + 16 * dt + fq * 4) = w; }
                        s1 = fq_sum(s1); s2 = fq_sum(s2);
                        if (fq == 0) *(f32x2*)(STAT + (((rb + iq) * 4 + h) * 8 + vs) * 2) = (f32x2){s1, s2};
                        __syncthreads();
#pragma unroll
                        for (int dt = 0; dt < 4; ++dt)
#pragma unroll
                            for (int nt = 0; nt < 2; ++nt) { const unsigned lo = pk2(sacc[dt][nt][0], sacc[dt][nt][1]), hi = pk2(sacc[dt][nt][2], sacc[dt][nt][3]);
                                LAS bf16_t* d = STs + (16 * dt + fq * 4) * 264 + 32 * wave + 16 * nt + fr;
                                d[0] = (bf16_t)(lo & 0xffff); d[264] = (bf16_t)(lo >> 16); d[2 * 264] = (bf16_t)(hi & 0xffff); d[3 * 264] = (bf16_t)(hi >> 16); }
                    }
                }
            }
        } else if (s == 6) {
            if (kind != 2) continue;
            gm = pg8::Gemm{Xc, Wb + W_MIN + (size_t)4096 * 1024, T, 2048, 1024, 1024};
            E.mode = pg8::M_RETG; E.out = ACT + 2048; E.ldc = 6144; E.ssp = SSP; E.nparts = 16; E.stat = STAT; is_gemm = true;
        } else if (s == 7) {
            if (kind == 0) gm = pg8::Gemm{ACT + (size_t)2 * T * 1024, Wb + W_MOUT, T, 1024, 1024, 1024};
            else if (kind == 1) gm = pg8::Gemm{ACT + (size_t)2 * T * 1024, Wb + W_MOUT, T, 1024, 1024, 1024};
            else gm = pg8::Gemm{ACT + 2048, Wb + W_MOUT, T, 1024, 2048, 6144};
            E.mode = pg8::M_YRES; E.stab = (LAS float*)(lds + 131072); E.out = Xc; E.ps = PS; E.ps2 = SSP; E.gain = ng + 3 * 1024; E.coef = 1.f; E.cnt = CNT + (size_t)(L * 3 + 1) * 128 * 16; is_gemm = true;
        } else if (s == 12) {
            gm = pg8::Gemm{PB, Wb + W_PROJ, T, 1024, 256, 256};
            E.mode = pg8::M_PLAIN; E.out = Yo; E.ldc = 1024; E.nparts = 0; is_gemm = true; do_sync = false;
        } else {
            gm = pg8::Gemm{Xc, Wb + W_GATE, T, 1024, 1024, 1024};
            E.mode = pg8::M_GATE; E.ssp = SSP; E.nparts = 16; E.ps = PS; E.xin = Xc; E.xout = (L == 3) ? X : nullptr; E.proj = Yo; E.xb = Yo; is_gemm = true;
        }
        if (is_gemm) {
            pg8::StaticOrder S; S.init(gm.M, gm.N, G, (int)blockIdx.x);
            pg8::gemm_phase(lds, gm, S, E, tid);
#ifdef GEMM_TWICE
            if (E.mode != pg8::M_GATE) { __syncthreads(); pg8::gemm_phase(lds, gm, S, E, tid); }
#endif
        }
        if (multi && do_sync && step + 1 < P.ph_hi) { if (P.ph_hi < 0) grid.sync(); xcd_barrier(xbar); }
    }
}

extern "C" void kernel_launch(void* const* d_in, const int* in_sizes, int n_in, void* d_out, int out_size, void* d_ws, size_t ws_size, hipStream_t stream) {
    static int grid = 0;
    if (grid == 0) {
        int dev = 0, cus = 0, per_cu = 0;
        hipGetDevice(&dev);
        hipDeviceGetAttribute(&cus, hipDeviceAttributeMultiprocessorCount, dev);
        hipFuncSetAttribute((const void*)fwd_kernel, hipFuncAttributeMaxDynamicSharedMemorySize, LDS_BYTES);
        hipOccupancyMaxActiveBlocksPerMultiprocessor(&per_cu, (const void*)fwd_kernel, 512, LDS_BYTES);
        if (per_cu < 1) per_cu = 1;
        grid = cus * per_cu;
        if (ws_size < WS_END) fprintf(stderr, "kernel_launch: workspace too small: %zu < %zu\n", ws_size, (size_t)WS_END);
    }
    hipMemsetAsync((char*)d_ws + WS_BAR, 0, 64 * 1024 + 12 * 128 * 64, stream);
    Params p{};
    for (int i = 0; i < 16; ++i) p.in[i] = (const float*)d_in[i];
    p.out = (float*)d_out; p.ws = (unsigned char*)d_ws; p.ph_lo = 0; p.ph_hi = NRUN;
    void* args[] = {&p};
    hipError_t e = hipLaunchCooperativeKernel((const void*)fwd_kernel, dim3(grid), dim3(512), args, LDS_BYTES, stream);
    if (e != hipSuccess) fprintf(stderr, "cooperative launch failed: %s (grid %d)\n", hipGetErrorString(e), grid);
}
```
